# Optimizing an MI355X kernel written in HIP

```python
import jax, jax.numpy as jnp
from jax import lax
import numpy as np

D_MODEL = 1024
BATCH = 8
SEQ = 8192
DEPTH = 1

ATTN_HEADS = 8
ATTN_KV_HEADS = 2
ATTN_HEAD_DIM = 64
WINDOW = 128
ATTN_BLOCK = 128
NUM_BUCKETS = 32
MAX_DISTANCE = 128
GLA_HEADS = 4
GLA_DK = 64
GLA_DV = 128
GLA_GATE_RANK = 16
GLA_GATE_NORM = 16.0
GLA_CHUNK = 64
D_FF = 4 * D_MODEL
EPS = 1e-6
N_MOD = 6

ATTN_Q = ATTN_HEADS * ATTN_HEAD_DIM
ATTN_KV = ATTN_KV_HEADS * ATTN_HEAD_DIM
GLA_K = GLA_HEADS * GLA_DK
GLA_V = GLA_HEADS * GLA_DV
SPLIT_SIZES = (ATTN_Q, ATTN_KV, ATTN_KV, GLA_K, GLA_K, GLA_V, GLA_V, GLA_GATE_RANK)
SPLIT_POINTS = tuple(int(s) for s in np.cumsum(SPLIT_SIZES)[:-1])
D_IN = int(sum(SPLIT_SIZES))
D_MIX = ATTN_Q + GLA_V

kernel_name = "hybrid_swa_gla_adaln_layer"


def rms_norm(x):
    x32 = x.astype(jnp.float32)
    return (x32 * lax.rsqrt(jnp.mean(x32 * x32, axis=-1, keepdims=True) + EPS)).astype(x.dtype)


def t5_causal_bucket(dist):
    max_exact = NUM_BUCKETS // 2
    d = np.maximum(dist, 0)
    large = max_exact + (np.log(np.maximum(d, max_exact) / max_exact)
                         / np.log(MAX_DISTANCE / max_exact) * (NUM_BUCKETS - max_exact)).astype(np.int32)
    large = np.minimum(large, NUM_BUCKETS - 1)
    return np.where(d < max_exact, d, large).astype(np.int32)


def sliding_window_attention(q, k, v, sinks, rel_bias):
    B, T, Hq, dh = q.shape
    Hkv = k.shape[2]
    G = Hq // Hkv
    L = ATTN_BLOCK
    nb = T // L
    qb = q.astype(jnp.float32).reshape(B, nb, L, Hkv, G, dh)
    kb = k.astype(jnp.float32).reshape(B, nb, L, Hkv, dh)
    vb = v.astype(jnp.float32).reshape(B, nb, L, Hkv, dh)
    pad = jnp.zeros_like(kb[:, :1])
    k2 = jnp.concatenate([jnp.concatenate([pad, kb[:, :-1]], axis=1), kb], axis=2)
    v2 = jnp.concatenate([jnp.concatenate([pad, vb[:, :-1]], axis=1), vb], axis=2)
    i = np.arange(L)[:, None]
    j = np.arange(2 * L)[None, :]
    dist = i + L - j
    band = (dist >= 0) & (dist < WINDOW)
    valid = np.broadcast_to(band, (nb, L, 2 * L)).copy()
    valid[0] &= np.broadcast_to(j >= L, (L, 2 * L))
    bucket = t5_causal_bucket(dist)
    bias = rel_bias.astype(jnp.float32)[bucket]
    bias = jnp.transpose(bias, (2, 0, 1)).reshape(Hkv, G, 1, L, 2 * L)
    s = jnp.einsum('bnqhgd,bnkhd->bhgnqk', qb, k2) * (dh ** -0.5) + bias
    s = jnp.where(valid, s, -jnp.inf)
    sink = sinks.astype(jnp.float32).reshape(Hkv, G)[None, :, :, None, None, None]
    m = jnp.maximum(jnp.max(s, axis=-1, keepdims=True), sink)
    p = jnp.exp(s - m)
    p = p / (jnp.sum(p, axis=-1, keepdims=True) + jnp.exp(sink - m))
    o = jnp.einsum('bhgnqk,bnkhd->bnqhgd', p, v2)
    return o.reshape(B, T, Hq * dh)


def gla_chunked(q, k, v, log_a):
    B, T, H, dk = q.shape
    dv = v.shape[-1]
    C = GLA_CHUNK
    n = T // C
    q = q.astype(jnp.float32).reshape(B, n, C, H, dk) * (dk ** -0.5)
    k = k.astype(jnp.float32).reshape(B, n, C, H, dk)
    v = v.astype(jnp.float32).reshape(B, n, C, H, dv)
    b = jnp.cumsum(log_a.astype(jnp.float32).reshape(B, n, C, H, dk), axis=2)
    b_last = b[:, :, -1:]
    q_t = q * jnp.exp(b)
    k_t = k * jnp.exp(-b)
    k_s = k * jnp.exp(b_last - b)
    causal = np.tril(np.ones((C, C), dtype=bool))
    A = jnp.where(causal, jnp.einsum('bnihd,bnjhd->bnhij', q_t, k_t), 0.0)
    o_intra = jnp.einsum('bnhij,bnjhv->bnihv', A, v)
    dS = jnp.einsum('bnjhd,bnjhv->bnhdv', k_s, v)
    decay = jnp.exp(b_last[:, :, 0])

    def step(S, inp):
        dS_n, dec_n = inp
        return dec_n[..., None] * S + dS_n, S

    S0 = jnp.zeros((B, H, dk, dv), jnp.float32)
    _, S_prev = lax.scan(step, S0, (jnp.moveaxis(dS, 1, 0), jnp.moveaxis(decay, 1, 0)))
    S_prev = jnp.moveaxis(S_prev, 0, 1)
    o_inter = jnp.einsum('bnihd,bnhdv->bnihv', q_t, S_prev)
    return (o_intra + o_inter).reshape(B, T, H, dv)


def setup_inputs(seed: int = 0) -> dict:
    key = jax.random.key(seed)
    ks = jax.random.split(key, 14)
    nrm = jax.random.normal
    f32 = jnp.float32
    return {
        "x": nrm(ks[0], (BATCH, SEQ, D_MODEL), f32),
        "c": nrm(ks[1], (BATCH, D_MODEL), f32),
        "w_ada": nrm(ks[2], (DEPTH, D_MODEL, N_MOD * D_MODEL), f32) * (0.5 * D_MODEL ** -0.5),
        "b_ada": nrm(ks[3], (DEPTH, N_MOD * D_MODEL), f32) * 0.01,
        "w_in": nrm(ks[4], (DEPTH, D_MODEL, D_IN), f32) * D_MODEL ** -0.5,
        "w_gate_up": nrm(ks[5], (DEPTH, GLA_GATE_RANK, GLA_K), f32) * GLA_GATE_RANK ** -0.5,
        "b_gate": nrm(ks[6], (DEPTH, GLA_K), f32) * 0.1,
        "gla_norm_g": 1.0 + 0.01 * nrm(ks[7], (DEPTH, GLA_DV), f32),
        "attn_sinks": nrm(ks[8], (DEPTH, ATTN_HEADS), f32) * 0.5,
        "rel_bias": nrm(ks[9], (NUM_BUCKETS, ATTN_HEADS), f32) * 0.5,
        "w_out": nrm(ks[10], (DEPTH, D_MIX, D_MODEL), f32) * D_MIX ** -0.5,
        "w_mlp_in": nrm(ks[11], (DEPTH, D_MODEL, D_FF), f32) * D_MODEL ** -0.5,
        "w_mlp_out": nrm(ks[12], (DEPTH, D_FF, D_MODEL), f32) * D_FF ** -0.5,
        "final_norm_g": 1.0 + 0.01 * nrm(ks[13], (D_MODEL,), f32),
    }


def reference(x, c, w_ada, b_ada, w_in, w_gate_up, b_gate, gla_norm_g, attn_sinks, rel_bias,
              w_out, w_mlp_in, w_mlp_out, final_norm_g):
    B, T, D = x.shape
    cond = jax.nn.silu(c)
    for l in range(DEPTH):
        ada = cond @ w_ada[l] + b_ada[l]
        shift1, scale1, gate1, shift2, scale2, gate2 = jnp.split(ada[:, None, :], N_MOD, axis=-1)

        h = rms_norm(x) * (1.0 + scale1) + shift1
        proj = h @ w_in[l]
        q_a, k_a, v_a, q_g, k_g, v_g, g_out, z_lr = jnp.split(proj, SPLIT_POINTS, axis=-1)

        attn = sliding_window_attention(
            q_a.reshape(B, T, ATTN_HEADS, ATTN_HEAD_DIM),
            k_a.reshape(B, T, ATTN_KV_HEADS, ATTN_HEAD_DIM),
            v_a.reshape(B, T, ATTN_KV_HEADS, ATTN_HEAD_DIM),
            attn_sinks[l], rel_bias).astype(x.dtype)

        log_a = jax.nn.log_sigmoid((z_lr @ w_gate_up[l] + b_gate[l]).astype(jnp.float32)) / GLA_GATE_NORM
        o = gla_chunked(
            q_g.reshape(B, T, GLA_HEADS, GLA_DK),
            k_g.reshape(B, T, GLA_HEADS, GLA_DK),
            v_g.reshape(B, T, GLA_HEADS, GLA_DV),
            log_a.reshape(B, T, GLA_HEADS, GLA_DK))
        o = rms_norm(o) * gla_norm_g[l].astype(jnp.float32)
        gla = (o.reshape(B, T, GLA_V) * jax.nn.silu(g_out.astype(jnp.float32))).astype(x.dtype)

        mix = jnp.concatenate([attn, gla], axis=-1) @ w_out[l]
        x = x + gate1 * mix

        h = rms_norm(x) * (1.0 + scale2) + shift2
        x = x + gate2 * (jnp.square(jax.nn.relu(h @ w_mlp_in[l])) @ w_mlp_out[l])
    return rms_norm(x) * final_norm_g
```

```cpp
#include <hip/hip_runtime.h>
#include <hip/hip_cooperative_groups.h>
#include <cstdio>
#include <cstdint>
namespace cg = cooperative_groups;

#ifndef MK_N_LAUNCHES
#define MK_N_LAUNCHES 10
#endif

constexpr int BATCH = 8, T = 8192, D = 1024, M = BATCH * T, FF = 4096;
constexpr int NPROJ = 2560;
constexpr int DIN = 2320;
constexpr float EPS = 1e-6f;
constexpr float LOG2E = 1.4426950408889634f;
constexpr int NPHASE = 10;

constexpr size_t MiB = 1u << 20;
constexpr size_t WS_CTL = 0, CTL_ZERO_BYTES = 1 * MiB;
constexpr size_t WS_ADA = 512 * 1024;
constexpr size_t WS_WIN = 2 * MiB, WS_WOUT = 8 * MiB, WS_W1 = 10 * MiB, WS_W2 = 18 * MiB;
constexpr size_t WS_SLOC = 32 * MiB, WS_ECUM = 48 * MiB;
constexpr size_t WS_XN = 64 * MiB;
constexpr size_t WS_QA = 192 * MiB, WS_KVA = 256 * MiB, WS_QG = 288 * MiB, WS_KG = 320 * MiB, WS_VG = 352 * MiB, WS_GO = 416 * MiB, WS_LA = 480 * MiB, WS_MIX = 544 * MiB;
constexpr size_t WS_H = 192 * MiB;
constexpr size_t WS_END = 704 * MiB;

constexpr int LDS_BYTES = 147456;

__constant__ unsigned char T5_BUCKET[128] = {0, 1, 2, 3, 4, 5, 6, 7, 8, 9, 10, 11, 12, 13, 14, 15, 16, 16, 16, 17, 17, 18, 18, 18, 19, 19, 19, 20, 20, 20, 20, 21, 21, 21, 21, 22, 22, 22, 22, 22, 23, 23, 23, 23, 23, 23, 24, 24, 24, 24, 24, 24, 25, 25, 25, 25, 25, 25, 25, 26, 26, 26, 26, 26, 26, 26, 26, 27, 27, 27, 27, 27, 27, 27, 27, 27, 27, 28, 28, 28, 28, 28, 28, 28, 28, 28, 28, 29, 29, 29, 29, 29, 29, 29, 29, 29, 29, 29, 29, 30, 30, 30, 30, 30, 30, 30, 30, 30, 30, 30, 30, 30, 30, 31, 31, 31, 31, 31, 31, 31, 31, 31, 31, 31, 31, 31, 31, 31};

namespace pg8 {
#define PG8_LAS __attribute__((address_space(3)))
typedef unsigned short bf16_t;
typedef short bf16x8 __attribute__((ext_vector_type(8)));
typedef float f32x4 __attribute__((ext_vector_type(4)));
typedef unsigned u32x4 __attribute__((ext_vector_type(4)));
constexpr int BM = 256, BK = 64, HALF = 128, HTB = HALF * BK * 2  , STAGE_BYTES = 8 * HTB, NXCD = 8, WGM = 8;

__host__ __device__ __forceinline__ int lds_byte(int r, int c) { const int st = (r >> 4) * 2 + (c >> 5), rr = r & 15, cc = c & 31, ob = rr * 64 + cc * 2; return st * 1024 + (ob ^ (((ob >> 9) & 1) << 5)); }
__host__ __device__ __forceinline__ void stage_rc(int b, int& R, int& C) { const int st = b / 1024, sb = b % 1024, swz = sb ^ (((sb >> 9) & 1) << 5); R = (st >> 1) * 16 + swz / 64; C = (st & 1) * 32 + (swz % 64) / 2; }
__host__ __device__ __forceinline__ int perm32(int rho) { const int n = rho >> 4, i = rho & 15; return 8 * (i >> 2) + 4 * n + (i & 3); }

struct Unit { int pm, pn; };
struct Gemm { const bf16_t* A; const bf16_t* Bt; int M, N, K; };

struct StaticOrder {
    int nM, nN, nwg, G, c;
    __host__ __device__ void init(int M, int N, int G_, int c_) { nM = M / BM; nN = N / BM; nwg = nM * nN; G = G_; c = c_; }
    __host__ __device__ bool next(int i, Unit& u) const {
        const long L = (long)i * G + c; if (L >= nwg) return false;
        int wgid = (int)L; { const int q = nwg / NXCD, r = nwg % NXCD, xcd = wgid % NXCD, off = wgid / NXCD; wgid = (xcd < r ? xcd * (q + 1) : r * (q + 1) + (xcd - r) * q) + off; }
        const int nig = WGM * nN, gid = wgid / nig, fm = gid * WGM, gsz = (nM - fm) < WGM ? (nM - fm) : WGM;
        u.pm = fm + ((wgid % nig) % gsz); u.pn = (wgid % nig) / gsz; return true;
    }
    __device__ __forceinline__ void a_ready(const Unit&) const {}
    __device__ __forceinline__ void done(const Unit&) const {}
};

__device__ __forceinline__ unsigned cvt_pk_bf16(float lo, float hi) { unsigned r; asm volatile("v_cvt_pk_bf16_f32 %0, %1, %2" : "=v"(r) : "v"(lo), "v"(hi)); return r; }
typedef float f32x2 __attribute__((ext_vector_type(2)));
__device__ __forceinline__ float silu_f(float v) { return v / (1.f + __expf(-v)); }
__device__ __forceinline__ float logsig_f(float v) { return fminf(v, 0.f) - __logf(1.f + __expf(-fabsf(v))); }

struct EpiProj {
    static constexpr bool PERM = true, AFTER_DRAIN = false;
    bf16_t *QA, *KVA, *QG, *KG, *VG, *GO; float* LA; const float* b_gate;
    __device__ __forceinline__ void operator()(const f32x4 (&acc)[2][2][4][2], const Unit& u, int wr, int wc, int fr, int fq) const {
        const int row0 = u.pm * BM + wr * 64 + fr, ct = wc * 32 + 8 * fq, pn = u.pn;
        if (pn == 9) {
            f32x4 bg[2][2];
#pragma unroll
            for (int bj = 0; bj < 2; ++bj)
#pragma unroll
                for (int n = 0; n < 2; ++n) bg[bj][n] = *(const f32x4*)(b_gate + ct + bj * HALF + 4 * n);
#pragma unroll
            for (int ai = 0; ai < 2; ++ai)
#pragma unroll
                for (int m = 0; m < 4; ++m) { float* rowp = LA + (size_t)(row0 + ai * HALF + m * 16) * 256 + ct;
#pragma unroll
                    for (int bj = 0; bj < 2; ++bj)
#pragma unroll
                        for (int n = 0; n < 2; ++n) { const f32x4 v = acc[ai][bj][m][n] + bg[bj][n]; f32x4 o;
                            o[0] = logsig_f(v[0]) * 0.0625f; o[1] = logsig_f(v[1]) * 0.0625f; o[2] = logsig_f(v[2]) * 0.0625f; o[3] = logsig_f(v[3]) * 0.0625f;
                            *(f32x4*)(rowp + bj * HALF + 4 * n) = o; } }
            return;
        }
        bf16_t* base; int ldc, coff = 0; float sc = 1.f;
        if (pn < 2) { base = QA; ldc = 512; coff = pn * 256; sc = 0.125f * 1.4426950408889634f; }
        else if (pn == 2) { base = KVA; ldc = 256; }
        else if (pn == 3) { base = QG; ldc = 256; sc = 0.125f; }
        else if (pn == 4) { base = KG; ldc = 256; }
        else if (pn < 7) { base = VG; ldc = 512; coff = (pn - 5) * 256; }
        else { base = GO; ldc = 512; coff = (pn - 7) * 256; }
        const bool act = pn >= 7;
#pragma unroll
        for (int ai = 0; ai < 2; ++ai)
#pragma unroll
            for (int m = 0; m < 4; ++m) { bf16_t* rowp = base + (size_t)(row0 + ai * HALF + m * 16) * ldc + coff + ct;
#pragma unroll
                for (int bj = 0; bj < 2; ++bj) { f32x4 v0 = acc[ai][bj][m][0], v1 = acc[ai][bj][m][1];
                    if (act) { v0[0] = silu_f(v0[0]); v0[1] = silu_f(v0[1]); v0[2] = silu_f(v0[2]); v0[3] = silu_f(v0[3]); v1[0] = silu_f(v1[0]); v1[1] = silu_f(v1[1]); v1[2] = silu_f(v1[2]); v1[3] = silu_f(v1[3]); }
                    else { v0 = v0 * sc; v1 = v1 * sc; }
                    u32x4 w; w.x = cvt_pk_bf16(v0[0], v0[1]); w.y = cvt_pk_bf16(v0[2], v0[3]); w.z = cvt_pk_bf16(v1[0], v1[1]); w.w = cvt_pk_bf16(v1[2], v1[3]);
                    *(u32x4*)(rowp + bj * HALF) = w; } }
    }
};
struct EpiResid {
    static constexpr bool PERM = false, AFTER_DRAIN = false;
    const float* base; float* out; const float* gate;
    __device__ __forceinline__ void operator()(const f32x4 (&acc)[2][2][4][2], const Unit& u, int wr, int wc, int fr, int fq) const {
        const int row0 = u.pm * BM + wr * 64 + fr, col0 = u.pn * BM + wc * 32 + 4 * fq, b = u.pm >> 5;
        f32x4 gv[2][2];
#pragma unroll
        for (int bj = 0; bj < 2; ++bj)
#pragma unroll
            for (int n = 0; n < 2; ++n) gv[bj][n] = *(const f32x4*)(gate + (size_t)b * 6144 + col0 + bj * HALF + n * 16);
#pragma unroll
        for (int ai = 0; ai < 2; ++ai)
#pragma unroll
            for (int m = 0; m < 4; ++m) { const size_t off = (size_t)(row0 + ai * HALF + m * 16) * 1024 + col0;
#pragma unroll
                for (int bj = 0; bj < 2; ++bj)
#pragma unroll
                    for (int n = 0; n < 2; ++n) { const f32x4 bs = *(const f32x4*)(base + off + bj * HALF + n * 16); *(f32x4*)(out + off + bj * HALF + n * 16) = bs + gv[bj][n] * acc[ai][bj][m][n]; }
                if (m & 1) asm volatile("" ::: "memory"); }
    }
};
struct EpiRelu2 {
    static constexpr bool PERM = true, AFTER_DRAIN = false;
    bf16_t* H;
    __device__ __forceinline__ void operator()(const f32x4 (&acc)[2][2][4][2], const Unit& u, int wr, int wc, int fr, int fq) const {
        const int row0 = u.pm * BM + wr * 64 + fr, col0 = u.pn * BM + wc * 32 + 8 * fq;
#pragma unroll
        for (int ai = 0; ai < 2; ++ai)
#pragma unroll
            for (int m = 0; m < 4; ++m) { bf16_t* rowp = H + (size_t)(row0 + ai * HALF + m * 16) * 4096 + col0;
#pragma unroll
                for (int bj = 0; bj < 2; ++bj) { f32x4 v0 = acc[ai][bj][m][0], v1 = acc[ai][bj][m][1];
                    v0 = __builtin_elementwise_max(v0, (f32x4){0.f, 0.f, 0.f, 0.f}); v1 = __builtin_elementwise_max(v1, (f32x4){0.f, 0.f, 0.f, 0.f}); v0 = v0 * v0; v1 = v1 * v1;
                    u32x4 w; w.x = cvt_pk_bf16(v0[0], v0[1]); w.y = cvt_pk_bf16(v0[2], v0[3]); w.z = cvt_pk_bf16(v1[0], v1[1]); w.w = cvt_pk_bf16(v1[2], v1[3]);
                    *(u32x4*)(rowp + bj * HALF) = w; } }
    }
};

template <class Epi, class Sched, bool ALIGN_EPI = false, bool SP2 = false>
__device__ __forceinline__ void gemm_phase(PG8_LAS unsigned char* lds, const Gemm g, const Sched& S, const Epi& E) {
    const int tid = threadIdx.x, wid = __builtin_amdgcn_readfirstlane(tid >> 6), lane = tid & 63, wr = wid >> 2, wc = wid & 3, fr = lane & 15, fq = lane >> 4;
    const int K = g.K, nt = K / BK;
    unsigned voffA[2], voffB[2];
#pragma unroll
    for (int i = 0; i < 2; ++i) { int R, C; stage_rc(tid * 16 + i * 8192, R, C); const int Rb = Epi::PERM ? ((R & ~31) + perm32(R & 31)) : R;
        voffA[i] = (unsigned)(R * K + C) * 2u; voffB[i] = (unsigned)(Rb * K + C) * 2u; }
    const size_t kstep = (size_t)(BK * 2);
    const size_t hstep = (size_t)HALF * K * 2;
    const size_t tstep = 2 * hstep;
    const unsigned ldsw = (unsigned)wid * 1024u;
    const int aoff = lds_byte(wr * 64 + fr, fq * 8), boff = lds_byte(wc * 32 + fr, fq * 8);
#define PG8_SA(b, h) (((b) * 2 + (h)) * HTB)
#define PG8_SB(b, h) ((4 + (b) * 2 + (h)) * HTB)
#define PG8_STAGE(bufoff, gbase, voff) do { _Pragma("unroll") for (int _i = 0; _i < 2; ++_i) \
        __builtin_amdgcn_global_load_lds((const unsigned*)((const char*)(gbase) + (voff)[_i]), (PG8_LAS unsigned*)(lds + (bufoff) + ldsw + _i * 8192), 16, 0, 0); } while (0)
#define PG8_LDA(dst, b, h) do { _Pragma("unroll") for (int m = 0; m < 4; ++m) _Pragma("unroll") for (int k = 0; k < 2; ++k) dst[m][k] = *(const PG8_LAS bf16x8*)(lds + PG8_SA(b, h) + aoff + m * 2048 + k * 1024); } while (0)
#define PG8_LDB(dst, b, h) do { _Pragma("unroll") for (int n = 0; n < 2; ++n) _Pragma("unroll") for (int k = 0; k < 2; ++k) dst[n][k] = *(const PG8_LAS bf16x8*)(lds + PG8_SB(b, h) + boff + n * 2048 + k * 1024); } while (0)
#define PG8_MMA(ai, bj, At, Bt) do { __builtin_amdgcn_s_setprio(1); _Pragma("unroll") for (int m = 0; m < 4; ++m) _Pragma("unroll") for (int n = 0; n < 2; ++n) _Pragma("unroll") for (int k = 0; k < 2; ++k) \
        acc[ai][bj][m][n] = __builtin_amdgcn_mfma_f32_16x16x32_bf16(Bt[n][k], At[m][k], acc[ai][bj][m][n], 0, 0, 0); __builtin_amdgcn_s_setprio(0); } while (0)
#define PG8_WAIT_V(n) asm volatile("s_waitcnt vmcnt(" #n ")" ::: "memory")
#define PG8_WAIT_L(n) asm volatile("s_waitcnt lgkmcnt(" #n ")" ::: "memory")
#define PG8_BAR __builtin_amdgcn_s_barrier()
#define PG8_SCHED __builtin_amdgcn_sched_barrier(0)
    Unit cur, nxt; int ui = 0;
    if (!S.next(0, cur)) return;
    f32x4 acc[2][2][4][2];
#pragma unroll
    for (int a = 0; a < 2; ++a)
#pragma unroll
        for (int b = 0; b < 2; ++b)
#pragma unroll
            for (int m = 0; m < 4; ++m)
#pragma unroll
                for (int n = 0; n < 2; ++n) acc[a][b][m][n] = (f32x4){0.f, 0.f, 0.f, 0.f};
    bf16x8 At[4][2], B0[2][2], B1[2][2];
    const char* cA = (const char*)g.A + (size_t)cur.pm * tstep; const char* cB = (const char*)g.Bt + (size_t)cur.pn * tstep;
    S.a_ready(cur);
    if constexpr (SP2) {
        PG8_STAGE(PG8_SB(0, 0), cB, voffB); PG8_STAGE(PG8_SB(0, 1), cB + hstep, voffB); PG8_STAGE(PG8_SA(0, 0), cA, voffA); PG8_STAGE(PG8_SA(0, 1), cA + hstep, voffA);
        if (wr == 1) PG8_BAR;
        PG8_WAIT_V(2); PG8_BAR;
        PG8_STAGE(PG8_SB(1, 0), cB + kstep, voffB); PG8_STAGE(PG8_SA(1, 0), cA + kstep, voffA); PG8_STAGE(PG8_SB(1, 1), cB + hstep + kstep, voffB);
        PG8_WAIT_V(6); PG8_BAR;
    } else {
        PG8_STAGE(PG8_SB(0, 0), cB, voffB); PG8_STAGE(PG8_SA(0, 0), cA, voffA); PG8_STAGE(PG8_SB(0, 1), cB + hstep, voffB); PG8_STAGE(PG8_SA(0, 1), cA + hstep, voffA);
        if (wr == 1) PG8_BAR;
        PG8_WAIT_V(4); PG8_BAR;
        PG8_STAGE(PG8_SB(1, 0), cB + kstep, voffB); PG8_STAGE(PG8_SA(1, 0), cA + kstep, voffA); PG8_STAGE(PG8_SB(1, 1), cB + hstep + kstep, voffB);
        PG8_WAIT_V(6); PG8_BAR;
    }
    for (;;) {
        const bool has_next = S.next(ui + 1, nxt);
        const char* nA = has_next ? (const char*)g.A + (size_t)nxt.pm * tstep : cA; const char* nB = has_next ? (const char*)g.Bt + (size_t)nxt.pn * tstep : cB;
        for (int t = 0; t < nt; t += 2) {
            const bool last = (t == nt - 2);
            const char* a1 = cA + (size_t)(t + 1) * kstep;
            const char* a2 = last ? nA : cA + (size_t)(t + 2) * kstep; const char* b2 = last ? nB : cB + (size_t)(t + 2) * kstep;
            const char* a3 = a2 + kstep; const char* b3 = b2 + kstep;
            if (last && has_next) S.a_ready(nxt);
            if constexpr (SP2) {
            PG8_LDB(B0, 0, 0); PG8_LDB(B1, 0, 1); PG8_SCHED; PG8_LDA(At, 0, 0); PG8_STAGE(PG8_SA(1, 1), a1 + hstep, voffA);
            PG8_WAIT_V(8); PG8_WAIT_L(0); PG8_BAR; PG8_MMA(0, 0, At, B0); PG8_MMA(0, 1, At, B1); PG8_BAR; PG8_SCHED;
            PG8_LDA(At, 0, 1); PG8_STAGE(PG8_SB(0, 0), b2, voffB); PG8_STAGE(PG8_SB(0, 1), b2 + hstep, voffB); PG8_STAGE(PG8_SA(0, 0), a2, voffA);
            PG8_WAIT_V(8); PG8_WAIT_L(0); PG8_BAR; PG8_MMA(1, 0, At, B0); PG8_MMA(1, 1, At, B1); PG8_BAR; PG8_SCHED;
            PG8_LDB(B0, 1, 0); PG8_LDB(B1, 1, 1); PG8_SCHED; PG8_LDA(At, 1, 0); PG8_STAGE(PG8_SA(0, 1), a2 + hstep, voffA);
            PG8_WAIT_V(8); PG8_WAIT_L(0); PG8_BAR; PG8_MMA(0, 0, At, B0); PG8_MMA(0, 1, At, B1); PG8_BAR; PG8_SCHED;
            PG8_LDA(At, 1, 1); PG8_STAGE(PG8_SB(1, 0), b3, voffB); PG8_STAGE(PG8_SB(1, 1), b3 + hstep, voffB); PG8_STAGE(PG8_SA(1, 0), a3, voffA);
            PG8_WAIT_V(8); PG8_WAIT_L(0); PG8_BAR; PG8_MMA(1, 0, At, B0); PG8_MMA(1, 1, At, B1); PG8_BAR; PG8_SCHED;
            } else {
            PG8_LDB(B0, 0, 0); PG8_SCHED; PG8_LDA(At, 0, 0); PG8_STAGE(PG8_SA(1, 1), a1 + hstep, voffA);
            PG8_WAIT_L(8); PG8_BAR; PG8_WAIT_L(0); PG8_MMA(0, 0, At, B0); PG8_BAR; PG8_SCHED;
            PG8_LDB(B1, 0, 1); PG8_STAGE(PG8_SB(0, 0), b2, voffB);
            PG8_BAR; PG8_WAIT_L(0); PG8_MMA(0, 1, At, B1); PG8_BAR;
            PG8_LDA(At, 0, 1); PG8_STAGE(PG8_SA(0, 0), a2, voffA);
            PG8_BAR; PG8_WAIT_L(0); PG8_MMA(1, 0, At, B0); PG8_BAR; PG8_SCHED;
            PG8_STAGE(PG8_SB(0, 1), b2 + hstep, voffB);
            PG8_WAIT_V(6); PG8_BAR; PG8_MMA(1, 1, At, B1); PG8_BAR;
            PG8_LDB(B0, 1, 0); PG8_SCHED; PG8_LDA(At, 1, 0); PG8_STAGE(PG8_SA(0, 1), a2 + hstep, voffA);
            PG8_WAIT_L(8); PG8_BAR; PG8_WAIT_L(0); PG8_MMA(0, 0, At, B0); PG8_BAR; PG8_SCHED;
            PG8_LDB(B1, 1, 1); PG8_STAGE(PG8_SB(1, 0), b3, voffB);
            PG8_BAR; PG8_WAIT_L(0); PG8_MMA(0, 1, At, B1); PG8_BAR;
            PG8_LDA(At, 1, 1); PG8_STAGE(PG8_SA(1, 0), a3, voffA);
            PG8_BAR; PG8_WAIT_L(0); PG8_MMA(1, 0, At, B0); PG8_BAR; PG8_SCHED;
            PG8_STAGE(PG8_SB(1, 1), b3 + hstep, voffB);
            PG8_WAIT_V(6); PG8_BAR; PG8_MMA(1, 1, At, B1); PG8_BAR;
            }
        }
        if constexpr (ALIGN_EPI) { if (wr == 0) PG8_BAR; }
        if constexpr (!Epi::AFTER_DRAIN) { E(acc, cur, wr, wc, fr, fq); S.done(cur); }
        if (!has_next) break;
#pragma unroll
        for (int a = 0; a < 2; ++a)
#pragma unroll
            for (int b = 0; b < 2; ++b)
#pragma unroll
                for (int m = 0; m < 4; ++m)
#pragma unroll
                    for (int n = 0; n < 2; ++n) acc[a][b][m][n] = (f32x4){0.f, 0.f, 0.f, 0.f};
        cur = nxt; cA = nA; cB = nB; ++ui;
        if constexpr (ALIGN_EPI) { if (wr == 1) PG8_BAR; }
    }
    PG8_WAIT_V(0);
    if constexpr (!ALIGN_EPI) { if (wr == 0) PG8_BAR; }
    PG8_BAR;
    if constexpr (Epi::AFTER_DRAIN) { E.fused(acc, cur, wr, wc, fr, fq, lds, wid, lane); S.done(cur); }
#undef PG8_SA
#undef PG8_SB
#undef PG8_STAGE
#undef PG8_LDA
#undef PG8_LDB
#undef PG8_MMA
#undef PG8_WAIT_V
#undef PG8_WAIT_L
#undef PG8_BAR
#undef PG8_SCHED
}
}
#define GAS __attribute__((address_space(1)))
#define LAS __attribute__((address_space(3)))
typedef unsigned short bf16;
typedef unsigned v4u __attribute__((ext_vector_type(4)));
typedef float f32x4 __attribute__((ext_vector_type(4)));
typedef short bf16x8 __attribute__((ext_vector_type(8)));
typedef GAS unsigned gu32;
typedef GAS unsigned long long gu64;
#define RLX_AGENT __ATOMIC_RELAXED, __HIP_MEMORY_SCOPE_AGENT
#define LDS_WAIT() asm volatile("s_waitcnt lgkmcnt(0)" ::: "memory")
#define VM_WAIT() asm volatile("s_waitcnt vmcnt(0)" ::: "memory")
__device__ __forceinline__ unsigned long long rt() { return __builtin_amdgcn_s_memrealtime(); }
__device__ __forceinline__ unsigned f2bf(float f) { unsigned u = __builtin_bit_cast(unsigned, f); return (u + 0x7fffu + ((u >> 16) & 1u)) >> 16; }
__device__ __forceinline__ unsigned pk2(float lo, float hi) { return f2bf(lo) | (f2bf(hi) << 16); }

#define XB_TMO      128
#define XB_XCNT(j)  (256  + 64 * (j))
#define XB_XSUB(j)  (1280 + 64 * (j))
#define XB_XGEN(j)  (2304 + 64 * (j))
#define XB_TOP      3328
#define XB_TOPGEN   3392
#define XCD_BAR_WORDS 3456
#define XB_SPIN_CAP (1u << 18)

__device__ __forceinline__ unsigned xb_ld(unsigned* p)              { return __hip_atomic_load(p, __ATOMIC_RELAXED, __HIP_MEMORY_SCOPE_AGENT); }
__device__ __forceinline__ unsigned xb_add(unsigned* p, unsigned v) { return __hip_atomic_fetch_add(p, v, __ATOMIC_RELAXED, __HIP_MEMORY_SCOPE_AGENT); }
__device__ __forceinline__ unsigned xb_xcc_id() { return (unsigned)__builtin_amdgcn_s_getreg((3 << 11) | 20) & 0xFu; }
#define XB_SPIN(cond, bar) do { unsigned _sp = 0; while (cond) { __builtin_amdgcn_s_sleep(1); \
    if ((++_sp & 255u) == 0u) { if (xb_ld(&(bar)[XB_TMO])) break; if (_sp > XB_SPIN_CAP) { atomicAdd(&(bar)[XB_TMO], 1u); break; } } } } while (0)

struct XcdBarrier {
    unsigned* bar; unsigned x;
    volatile LAS unsigned* st;
};

__device__ __forceinline__ XcdBarrier xcd_barrier_post(unsigned* bar, volatile LAS unsigned* st) {
    XcdBarrier b; b.bar = bar; b.x = xb_xcc_id(); b.st = st;
    if (threadIdx.x == 0) (void)xb_add(&bar[XB_XCNT(b.x)], 1u);
    return b;
}
__device__ __forceinline__ void xcd_barrier_complete(unsigned* bar, unsigned x, unsigned& nloc, unsigned& nx) {
    const unsigned G = gridDim.x * gridDim.y * gridDim.z;
    unsigned sum, cnt, mine, sp = 0u;
    for (;;) {
        sum = 0u; cnt = 0u; mine = 0u;
#pragma unroll
        for (unsigned j = 0; j < 16; ++j) { const unsigned c = xb_ld(&bar[XB_XCNT(j)]); sum += c; cnt += (c > 0u) ? 1u : 0u; mine = (j == x) ? c : mine; }
        if (sum == G) break;
        __builtin_amdgcn_s_sleep(1);
        if ((++sp & 255u) == 0u) { if (xb_ld(&bar[XB_TMO])) break; if (sp > XB_SPIN_CAP) { atomicAdd(&bar[XB_TMO], 1u); break; } }
    }
    nloc = mine > 0u ? mine : 1u; nx = cnt > 0u ? cnt : 1u;
}

__device__ __forceinline__ void xcd_barrier(const XcdBarrier& b) {
    asm volatile("s_waitcnt vmcnt(0)" ::: "memory");
    __syncthreads();
    if (threadIdx.x == 0) {
        unsigned* bar = b.bar;
        __builtin_amdgcn_s_waitcnt(0);
        unsigned nloc = b.st[0], nx = b.st[1];
        if (nloc == 0u) { xcd_barrier_complete(bar, b.x, nloc, nx); b.st[0] = nloc; b.st[1] = nx; }
        const unsigned old = xb_add(&bar[XB_XSUB(b.x)], 1u);
        const unsigned gen = old / nloc;
        if (old + 1u == (gen + 1u) * nloc) {
            __builtin_amdgcn_fence(__ATOMIC_RELEASE, "agent");
            asm volatile("s_waitcnt vmcnt(0)" ::: "memory");
            const unsigned og = xb_add(&bar[XB_TOP], 1u);
            const unsigned tg = og / nx;
            if (og + 1u == (tg + 1u) * nx) xb_add(&bar[XB_TOPGEN], 1u);
            else XB_SPIN(xb_ld(&bar[XB_TOPGEN]) == tg, bar);
            __builtin_amdgcn_fence(__ATOMIC_ACQUIRE, "agent");
            xb_add(&bar[XB_XGEN(b.x)], 1u);
            asm volatile("s_waitcnt vmcnt(0)" ::: "memory");
        } else {
            XB_SPIN(xb_ld(&bar[XB_XGEN(b.x)]) == gen, bar);
            __builtin_amdgcn_fence(__ATOMIC_ACQUIRE, "agent");
            asm volatile("s_waitcnt vmcnt(0)" ::: "memory");
        }
    }
    __syncthreads();
}

__device__ __forceinline__ float bf2f(unsigned short h) { return __uint_as_float((unsigned)h << 16); }
__device__ __forceinline__ float wave_sum(float v) {
#pragma unroll
    for (int o = 1; o < 64; o <<= 1) v += __shfl_xor(v, o);
    return v;
}
__device__ __forceinline__ void unpack8(const v4u w, float* f) {
    f[0] = __uint_as_float(w.x << 16); f[1] = __uint_as_float(w.x & 0xffff0000u); f[2] = __uint_as_float(w.y << 16); f[3] = __uint_as_float(w.y & 0xffff0000u);
    f[4] = __uint_as_float(w.z << 16); f[5] = __uint_as_float(w.z & 0xffff0000u); f[6] = __uint_as_float(w.w << 16); f[7] = __uint_as_float(w.w & 0xffff0000u);
}

struct Params { const float* in[14]; float* out; unsigned char* ws; int ph_lo, ph_hi; };
struct Ctx { LAS unsigned char* lds; int tid, lane, wave, gw, ngw; };

__device__ __forceinline__ void transpose_item(const float* W, int ldw, int nblk, int K, bf16* WT, LAS float* scr, int item, int lane) {
    const int kb = item / nblk, nb = item % nblk, k0 = 64 * kb, n0 = 32 * nb;
#pragma unroll 8
    for (int i = 0; i < 32; ++i) { const int kk = 2 * i + (lane >> 5); scr[kk * 33 + (lane & 31)] = W[(size_t)(k0 + kk) * ldw + n0 + (lane & 31)]; }
    LDS_WAIT(); asm volatile("" ::: "memory");
    const int c = lane & 7;
#pragma unroll
    for (int j = 0; j < 4; ++j) { const int n = (lane >> 3) + 8 * j; const LAS float* s = scr + (8 * c) * 33 + n;
        v4u o; o.x = pk2(s[0 * 33], s[1 * 33]); o.y = pk2(s[2 * 33], s[3 * 33]); o.z = pk2(s[4 * 33], s[5 * 33]); o.w = pk2(s[6 * 33], s[7 * 33]);
        *(GAS v4u*)(WT + (size_t)(n0 + n) * K + k0 + 8 * c) = o; }
    LDS_WAIT(); asm volatile("" ::: "memory");
}
__device__ __forceinline__ void p0_prologue(const Ctx& C, const Params& P) {
    LAS float* scr = (LAS float*)(C.lds + C.wave * 16384);
    unsigned char* ws = P.ws;
    const float* cin = P.in[1]; const float* w_ada = P.in[2]; const float* b_ada = P.in[3]; const float* w_in = P.in[4]; const float* wgu = P.in[5];
    float* ADA = (float*)(ws + WS_ADA);
    bf16* WIN = (bf16*)(ws + WS_WIN);
    constexpr int I_ADA = 96 * 8, I_IN = 16 * 72, I_OUT = 16 * 32, I_1 = 16 * 128, I_2 = 64 * 32, I_Z = 256 * 16;
    constexpr int NITEMS = I_ADA + I_IN + I_OUT + I_1 + I_2 + I_Z;
    for (int it = C.gw; it < NITEMS; it += C.ngw) {
        int r = it; const int lane = C.lane;
        if (r < I_ADA) {
            const int cgi = r >> 3, ks = r & 7, n = cgi * 64 + lane, k0 = ks * 128;
#pragma unroll
            for (int i = 0; i < 16; ++i) { const int idx = i * 64 + lane, b = idx >> 7, k = idx & 127; const float cv = cin[b * 1024 + k0 + k]; scr[k * 8 + b] = cv / (1.f + __expf(-cv)); }
            LDS_WAIT(); asm volatile("" ::: "memory");
            float a[8];
#pragma unroll
            for (int b = 0; b < 8; ++b) a[b] = 0.f;
#pragma unroll 4
            for (int k = 0; k < 128; ++k) { const float w = w_ada[(size_t)(k0 + k) * 6144 + n]; const f32x4 c0 = *(const LAS f32x4*)(scr + k * 8), c1 = *(const LAS f32x4*)(scr + k * 8 + 4);
                a[0] += c0[0] * w; a[1] += c0[1] * w; a[2] += c0[2] * w; a[3] += c0[3] * w; a[4] += c1[0] * w; a[5] += c1[1] * w; a[6] += c1[2] * w; a[7] += c1[3] * w; }
            const float bb = (ks == 0) ? b_ada[n] : 0.f;
#pragma unroll
            for (int b = 0; b < 8; ++b) atomicAdd(ADA + b * 6144 + n, a[b] + bb);
            LDS_WAIT(); asm volatile("" ::: "memory");
            continue; }
        r -= I_ADA;
        if (r < I_IN) { transpose_item(w_in, DIN, 72, D, WIN, scr, r, lane); continue; } r -= I_IN;
        if (r < I_OUT) { transpose_item(P.in[10], D, 32, D, (bf16*)(ws + WS_WOUT), scr, r, lane); continue; } r -= I_OUT;
        if (r < I_1) { transpose_item(P.in[11], FF, 128, D, (bf16*)(ws + WS_W1), scr, r, lane); continue; } r -= I_1;
        if (r < I_2) { transpose_item(P.in[12], D, 32, FF, (bf16*)(ws + WS_W2), scr, r, lane); continue; } r -= I_2;
        {
            const int n = r >> 4, k = (r & 15) * 64 + lane; const float* wr = w_in + (size_t)k * DIN + 2304; float acc = 0.f;
#pragma unroll
            for (int q = 0; q < 4; ++q) { const f32x4 wv = *(const f32x4*)(wr + 4 * q);
                acc += wv[0] * wgu[(4 * q + 0) * 256 + n] + wv[1] * wgu[(4 * q + 1) * 256 + n] + wv[2] * wgu[(4 * q + 2) * 256 + n] + wv[3] * wgu[(4 * q + 3) * 256 + n]; }
            WIN[(size_t)(2304 + n) * D + k] = (bf16)f2bf(acc);
        }
    }
}

__device__ __forceinline__ void xn_pass(const Ctx& C, const float* src, const float* ADA, int shift_off, int scale_off, bf16* XN) {
    for (int m = C.gw; m < M; m += C.ngw) {
        const GAS f32x4* xr = (const GAS f32x4*)(src + (size_t)m * D) + C.lane;
        f32x4 v[4]; float s = 0.f;
#pragma unroll
        for (int j = 0; j < 4; ++j) { v[j] = xr[64 * j]; s += (v[j].x * v[j].x + v[j].y * v[j].y) + (v[j].z * v[j].z + v[j].w * v[j].w); }
        const float rstd = 1.f / sqrtf(wave_sum(s) * (1.f / D) + EPS);
        const int b = m >> 13;
        const f32x4* sc = (const f32x4*)(ADA + b * 6144 + scale_off) + C.lane; const f32x4* sh = (const f32x4*)(ADA + b * 6144 + shift_off) + C.lane;
        GAS unsigned long long* o8 = (GAS unsigned long long*)(XN + (size_t)m * D) + C.lane;
#pragma unroll
        for (int j = 0; j < 4; ++j) { const f32x4 a = sc[64 * j], h = sh[64 * j]; const f32x4 o = v[j] * rstd * (a + 1.f) + h;
            o8[64 * j] = (unsigned long long)pk2(o.x, o.y) | ((unsigned long long)pk2(o.z, o.w) << 32); }
    }
}
__device__ __forceinline__ void final_norm_pass(const Ctx& C, float* xo, const float* g) {
    for (int m = C.gw; m < M; m += C.ngw) {
        GAS f32x4* xr = (GAS f32x4*)(xo + (size_t)m * D) + C.lane;
        f32x4 v[4]; float s = 0.f;
#pragma unroll
        for (int j = 0; j < 4; ++j) { v[j] = xr[64 * j]; s += (v[j].x * v[j].x + v[j].y * v[j].y) + (v[j].z * v[j].z + v[j].w * v[j].w); }
        const float rstd = 1.f / sqrtf(wave_sum(s) * (1.f / D) + EPS);
        const f32x4* gg = (const f32x4*)g + C.lane;
#pragma unroll
        for (int j = 0; j < 4; ++j) xr[64 * j] = v[j] * rstd * gg[64 * j];
    }
}

__device__ __forceinline__ void swa_naive_phase(const Ctx& C, const Params& P) {
    float* Ks = (float*)((unsigned char*)C.lds);
    LAS float* KsL = (LAS float*)C.lds; LAS float* VsL = KsL + 256 * 68; LAS float* BtL = VsL + 256 * 68;
    (void)Ks;
    const bf16* QA = (const bf16*)(P.ws + WS_QA); const bf16* KVA = (const bf16*)(P.ws + WS_KVA); bf16* MIX = (bf16*)(P.ws + WS_MIX);
    const float* sinks = P.in[8]; const float* rel_bias = P.in[9];
    const int t = C.tid;
    for (int unit = blockIdx.x; unit < 1024; unit += gridDim.x) {
        const int b = unit >> 7, kvh = (unit >> 6) & 1, nb = unit & 63;
        __syncthreads();
        { const int row = t >> 1, half = t & 1, pos = (nb - 1) * 128 + row;
          float kf[32], vf[32];
          if (pos >= 0) { const bf16* src = KVA + (size_t)(b * T + pos) * 256 + kvh * 64 + half * 32;
#pragma unroll
              for (int i = 0; i < 4; ++i) { unpack8(*(const v4u*)(src + 8 * i), kf + 8 * i); unpack8(*(const v4u*)(src + 128 + 8 * i), vf + 8 * i); } }
          else {
#pragma unroll
              for (int i = 0; i < 32; ++i) { kf[i] = 0.f; vf[i] = 0.f; } }
#pragma unroll
          for (int i = 0; i < 8; ++i) { *(LAS f32x4*)(KsL + row * 68 + half * 32 + 4 * i) = (f32x4){kf[4 * i], kf[4 * i + 1], kf[4 * i + 2], kf[4 * i + 3]};
                                        *(LAS f32x4*)(VsL + row * 68 + half * 32 + 4 * i) = (f32x4){vf[4 * i], vf[4 * i + 1], vf[4 * i + 2], vf[4 * i + 3]}; }
          const int g = t >> 7, dist = t & 127;
          BtL[t] = rel_bias[(int)T5_BUCKET[dist] * 8 + kvh * 4 + g] * LOG2E; }
        __syncthreads();
        const int g = t >> 7, i = t & 127, head = kvh * 4 + g; const size_t rowq = (size_t)b * T + nb * 128 + i;
        float q[64], o[64];
        { const bf16* qs = QA + rowq * 512 + head * 64;
#pragma unroll
          for (int k = 0; k < 8; ++k) unpack8(*(const v4u*)(qs + 8 * k), q + 8 * k); }
#pragma unroll
        for (int d = 0; d < 64; ++d) o[d] = 0.f;
        float mx = sinks[head] * LOG2E, l = 1.f;
        for (int dd = 0; dd < 128; ++dd) {
            const int j = i + 1 + dd;
            if (nb == 0 && j < 128) continue;
            float s = BtL[g * 128 + 127 - dd];
            const LAS float* kr = KsL + j * 68; const LAS float* vr = VsL + j * 68;
#pragma unroll
            for (int d = 0; d < 64; d += 4) { const f32x4 kv = *(const LAS f32x4*)(kr + d); s += q[d] * kv[0] + q[d + 1] * kv[1] + q[d + 2] * kv[2] + q[d + 3] * kv[3]; }
            const float mn = fmaxf(mx, s), cc = exp2f(mx - mn), p = exp2f(s - mn);
            l = l * cc + p; mx = mn;
#pragma unroll
            for (int d = 0; d < 64; d += 4) { const f32x4 vv = *(const LAS f32x4*)(vr + d); o[d] = o[d] * cc + p * vv[0]; o[d + 1] = o[d + 1] * cc + p * vv[1]; o[d + 2] = o[d + 2] * cc + p * vv[2]; o[d + 3] = o[d + 3] * cc + p * vv[3]; }
        }
        const float inv = 1.f / l;
        bf16* op = MIX + rowq * 1024 + head * 64;
#pragma unroll
        for (int k = 0; k < 8; ++k) { v4u w; w.x = pk2(o[8 * k] * inv, o[8 * k + 1] * inv); w.y = pk2(o[8 * k + 2] * inv, o[8 * k + 3] * inv); w.z = pk2(o[8 * k + 4] * inv, o[8 * k + 5] * inv); w.w = pk2(o[8 * k + 6] * inv, o[8 * k + 7] * inv);
            *(v4u*)(op + 8 * k) = w; }
    }
}

template <bool OUT> __device__ __forceinline__ void gla_naive_phase(const Ctx& C, const Params& P) {
    const int sub = C.tid >> 7, e = C.tid & 127;
    LAS float* R = (LAS float*)C.lds + sub * 7296;
    LAS float* Al = R, *Kl = R + 1024, *Ql = R + 2048, *Vl = R + 3072, *Ol = R + 5120, *Ll = R + 7168;
    const bf16* QG = (const bf16*)(P.ws + WS_QG); const bf16* KG = (const bf16*)(P.ws + WS_KG); const bf16* VG = (const bf16*)(P.ws + WS_VG); const bf16* GO = (const bf16*)(P.ws + WS_GO);
    const float* LA = (const float*)(P.ws + WS_LA); float* SLOC = (float*)(P.ws + WS_SLOC); float* ECUM = (float*)(P.ws + WS_ECUM); bf16* MIX = (bf16*)(P.ws + WS_MIX);
    const float* gng = P.in[7];
    for (int grp = blockIdx.x; grp < 128; grp += gridDim.x) {
        const int u = grp * 4 + sub, bh = u >> 4, j = u & 15, b = bh >> 2, h = bh & 3;
        const size_t tok0 = (size_t)b * T + j * 512;
        float S[64];
#pragma unroll
        for (int d = 0; d < 64; ++d) S[d] = 0.f;
        if (OUT) {
            for (int i = 0; i < j; ++i) { const int ui = bh * 16 + i;
#pragma unroll
                for (int d = 0; d < 64; ++d) S[d] = ECUM[ui * 64 + d] * S[d] + SLOC[((size_t)ui * 64 + d) * 128 + e]; }
        }
        float lsum = 0.f;
        for (int tb = 0; tb < 32; ++tb) {
            __syncthreads();
            { const int d = e & 63;
#pragma unroll
              for (int q = 0; q < 8; ++q) { const int r = (e >> 6) + 2 * q; const size_t tok = tok0 + tb * 16 + r;
                  const float la = LA[tok * 256 + h * 64 + d]; lsum += la; Al[r * 64 + d] = __expf(la);
                  Kl[r * 64 + d] = bf2f(KG[tok * 256 + h * 64 + d]);
                  if (OUT) Ql[r * 64 + d] = bf2f(QG[tok * 256 + h * 64 + d]); }
#pragma unroll
              for (int r = 0; r < 16; ++r) { const size_t tok = tok0 + tb * 16 + r; Vl[r * 128 + e] = bf2f(VG[tok * 512 + h * 128 + e]); } }
            __syncthreads();
            for (int r = 0; r < 16; ++r) {
                const float vt = Vl[r * 128 + e]; float o = 0.f;
#pragma unroll
                for (int d = 0; d < 64; d += 4) { const f32x4 a4 = *(const LAS f32x4*)(Al + r * 64 + d), k4 = *(const LAS f32x4*)(Kl + r * 64 + d);
                    S[d] = a4[0] * S[d] + k4[0] * vt; S[d + 1] = a4[1] * S[d + 1] + k4[1] * vt; S[d + 2] = a4[2] * S[d + 2] + k4[2] * vt; S[d + 3] = a4[3] * S[d + 3] + k4[3] * vt;
                    if (OUT) { const f32x4 q4 = *(const LAS f32x4*)(Ql + r * 64 + d); o += q4[0] * S[d] + q4[1] * S[d + 1] + q4[2] * S[d + 2] + q4[3] * S[d + 3]; } }
                if (OUT) Ol[r * 128 + e] = o;
            }
            if (OUT) {
                __syncthreads();
                const int ws2 = (C.tid >> 6) & 1, lane = C.lane;
                for (int rr = 0; rr < 8; ++rr) { const int r = ws2 * 8 + rr; const size_t tok = tok0 + tb * 16 + r;
                    const float x0 = Ol[r * 128 + lane], x1 = Ol[r * 128 + 64 + lane];
                    const float ss = wave_sum(x0 * x0 + x1 * x1); const float rn = 1.f / sqrtf(ss * (1.f / 128.f) + EPS);
                    const float g0 = bf2f(GO[tok * 512 + h * 128 + lane]), g1 = bf2f(GO[tok * 512 + h * 128 + 64 + lane]);
                    MIX[tok * 1024 + 512 + h * 128 + lane] = (bf16)f2bf(x0 * rn * gng[lane] * g0);
                    MIX[tok * 1024 + 512 + h * 128 + 64 + lane] = (bf16)f2bf(x1 * rn * gng[64 + lane] * g1); }
            }
        }
        if (!OUT) {
#pragma unroll
            for (int d = 0; d < 64; ++d) SLOC[((size_t)u * 64 + d) * 128 + e] = S[d];
            __syncthreads();
            Ll[e] = lsum;
            __syncthreads();
            if (e < 64) ECUM[u * 64 + e] = __expf(Ll[e] + Ll[e + 64]);
        }
    }
}

__global__ void __launch_bounds__(512, 2) fwd_kernel(Params P) {
    extern __shared__ __attribute__((aligned(16))) unsigned char lds[];
    cg::grid_group grid = cg::this_grid();
    Ctx C; C.lds = (LAS unsigned char*)lds; C.tid = threadIdx.x; C.lane = C.tid & 63; C.wave = __builtin_amdgcn_readfirstlane(C.tid >> 6);
    C.gw = blockIdx.x * 8 + C.wave; C.ngw = gridDim.x * 8;
    unsigned char* ws = P.ws;
    const float* ADA = (const float*)(ws + WS_ADA);
    bf16* XN = (bf16*)(ws + WS_XN);
    const int lo = P.ph_lo, hi = P.ph_hi;
#define IN(k) (lo <= (k) && (k) < hi)
#define SEAM(k) do { if (IN(k) && IN((k) + 1)) grid.sync(); } while (0)

    if (IN(0)) p0_prologue(C, P);
    SEAM(0);
    if (IN(1)) xn_pass(C, P.in[0], ADA, 0, 1024, XN);
    SEAM(1);
    if (IN(2)) {
        pg8::Gemm g{XN, (const bf16*)(ws + WS_WIN), M, NPROJ, D}; pg8::StaticOrder S; S.init(M, NPROJ, gridDim.x, (int)blockIdx.x);
        pg8::EpiProj E{(bf16*)(ws + WS_QA), (bf16*)(ws + WS_KVA), (bf16*)(ws + WS_QG), (bf16*)(ws + WS_KG), (bf16*)(ws + WS_VG), (bf16*)(ws + WS_GO), (float*)(ws + WS_LA), P.in[6]};
        pg8::gemm_phase<pg8::EpiProj, pg8::StaticOrder, true, true>(C.lds, g, S, E);
    }
    SEAM(2);
    if (IN(3)) { swa_naive_phase(C, P); __syncthreads(); gla_naive_phase<false>(C, P); }
    SEAM(3);
    if (IN(4)) gla_naive_phase<true>(C, P);
    SEAM(4);
    if (IN(5)) {
        pg8::Gemm g{(const bf16*)(ws + WS_MIX), (const bf16*)(ws + WS_WOUT), M, D, D}; pg8::StaticOrder S; S.init(M, D, gridDim.x, (int)blockIdx.x);
        pg8::EpiResid E{P.in[0], P.out, ADA + 2048};
        pg8::gemm_phase<pg8::EpiResid, pg8::StaticOrder, true, true>(C.lds, g, S, E);
    }
    SEAM(5);
    if (IN(6)) xn_pass(C, P.out, ADA, 3072, 4096, XN);
    SEAM(6);
    if (IN(7)) {
        pg8::Gemm g{XN, (const bf16*)(ws + WS_W1), M, FF, D}; pg8::StaticOrder S; S.init(M, FF, gridDim.x, (int)blockIdx.x);
        pg8::EpiRelu2 E{(bf16*)(ws + WS_H)};
        pg8::gemm_phase<pg8::EpiRelu2, pg8::StaticOrder, true, true>(C.lds, g, S, E);
    }
    SEAM(7);
    if (IN(8)) {
        pg8::Gemm g{(const bf16*)(ws + WS_H), (const bf16*)(ws + WS_W2), M, D, FF}; pg8::StaticOrder S; S.init(M, D, gridDim.x, (int)blockIdx.x);
        pg8::EpiResid E{P.out, P.out, ADA + 5120};
        pg8::gemm_phase<pg8::EpiResid, pg8::StaticOrder, true, true>(C.lds, g, S, E);
    }
    SEAM(8);
    if (IN(9)) final_norm_pass(C, P.out, P.in[13]);
#undef IN
#undef SEAM
}

extern "C" void kernel_launch(void* const* d_in, const int* in_sizes, int n_in, void* d_out, int out_size, void* d_ws, size_t ws_size, hipStream_t stream) {
    static int grid = 0;
    if (grid == 0) {
        if (n_in != 14 || in_sizes[0] != M * D || out_size != M * D || ws_size < WS_END) { fprintf(stderr, "kernel_launch: unexpected shapes: n_in %d in0 %d out %d ws %zu\n", n_in, n_in > 0 ? in_sizes[0] : -1, out_size, ws_size); grid = -1; return; }
        int dev = 0, cus = 0, per_cu = 0;
        if (hipGetDevice(&dev) != hipSuccess || hipDeviceGetAttribute(&cus, hipDeviceAttributeMultiprocessorCount, dev) != hipSuccess) { fprintf(stderr, "kernel_launch: device query failed\n"); grid = -1; return; }
        if (hipFuncSetAttribute((const void*)fwd_kernel, hipFuncAttributeMaxDynamicSharedMemorySize, LDS_BYTES) != hipSuccess) { fprintf(stderr, "kernel_launch: hipFuncSetAttribute failed\n"); grid = -1; return; }
        if (hipOccupancyMaxActiveBlocksPerMultiprocessor(&per_cu, (const void*)fwd_kernel, 512, LDS_BYTES) != hipSuccess || per_cu < 1) { fprintf(stderr, "kernel_launch: occupancy query says %d blocks per CU\n", per_cu); (void)hipGetLastError(); grid = -1; return; }
        grid = cus;
    }
    if (grid < 0) return;
    if (hipMemsetAsync((char*)d_ws + WS_CTL, 0, CTL_ZERO_BYTES, stream) != hipSuccess) { fprintf(stderr, "kernel_launch: memset failed\n"); return; }
    Params p{};
    for (int i = 0; i < 14; ++i) p.in[i] = (const float*)d_in[i];
    p.out = (float*)d_out; p.ws = (unsigned char*)d_ws;
    constexpr int NL = MK_N_LAUNCHES;
    for (int li = 0; li < NL; ++li) {
        if (NL == 1) { p.ph_lo = 0; p.ph_hi = NPHASE; } else { p.ph_lo = li; p.ph_hi = li + 1; }
        void* args[] = {&p};
        const hipError_t e = hipLaunchCooperativeKernel((const void*)fwd_kernel, dim3(grid), dim3(512), args, LDS_BYTES, stream);
        if (e != hipSuccess) { fprintf(stderr, "kernel_launch: cooperative launch %d failed: %s (grid %d)\n", li, hipGetErrorString(e), grid); break; }
    }
}
```

```cpp
#include <hip/hip_runtime.h>
#include <hip/hip_cooperative_groups.h>
#include <cstdio>
#include <cstdint>
namespace cg = cooperative_groups;

#ifndef MK_N_LAUNCHES
#define MK_N_LAUNCHES 1
#endif

constexpr int BATCH = 8, T = 8192, D = 1024, M = BATCH * T, FF = 4096;
constexpr int NPROJ = 2560;
constexpr int DIN = 2320;
constexpr float EPS = 1e-6f;
constexpr float LOG2E = 1.4426950408889634f;
constexpr int NPHASE = 10;

constexpr size_t MiB = 1u << 20;
constexpr size_t WS_CTL = 0, CTL_ZERO_BYTES = 1 * MiB;
constexpr size_t WS_ADA = 512 * 1024;
constexpr size_t WS_WIN = 2 * MiB, WS_WOUT = 8 * MiB, WS_W1 = 10 * MiB, WS_W2 = 18 * MiB;
constexpr size_t WS_SLOC = 32 * MiB, WS_ECUM = 48 * MiB;
constexpr size_t WS_XN = 64 * MiB;
constexpr size_t WS_QA = 192 * MiB, WS_KVA = 256 * MiB, WS_QG = 288 * MiB, WS_KG = 320 * MiB, WS_VG = 352 * MiB, WS_GO = 416 * MiB, WS_LA = 480 * MiB, WS_MIX = 544 * MiB;
constexpr size_t WS_H = 192 * MiB;
constexpr size_t WS_END = 704 * MiB;

constexpr int LDS_BYTES = 147456;

__constant__ unsigned char T5_BUCKET[128] = {0, 1, 2, 3, 4, 5, 6, 7, 8, 9, 10, 11, 12, 13, 14, 15, 16, 16, 16, 17, 17, 18, 18, 18, 19, 19, 19, 20, 20, 20, 20, 21, 21, 21, 21, 22, 22, 22, 22, 22, 23, 23, 23, 23, 23, 23, 24, 24, 24, 24, 24, 24, 25, 25, 25, 25, 25, 25, 25, 26, 26, 26, 26, 26, 26, 26, 26, 27, 27, 27, 27, 27, 27, 27, 27, 27, 27, 28, 28, 28, 28, 28, 28, 28, 28, 28, 28, 29, 29, 29, 29, 29, 29, 29, 29, 29, 29, 29, 29, 30, 30, 30, 30, 30, 30, 30, 30, 30, 30, 30, 30, 30, 30, 31, 31, 31, 31, 31, 31, 31, 31, 31, 31, 31, 31, 31, 31, 31};

namespace pg8 {
#define PG8_LAS __attribute__((address_space(3)))
typedef unsigned short bf16_t;
typedef short bf16x8 __attribute__((ext_vector_type(8)));
typedef float f32x4 __attribute__((ext_vector_type(4)));
typedef unsigned u32x4 __attribute__((ext_vector_type(4)));
constexpr int BM = 256, BK = 64, HALF = 128, HTB = HALF * BK * 2  , STAGE_BYTES = 8 * HTB, NXCD = 8, WGM = 8;

__host__ __device__ __forceinline__ int lds_byte(int r, int c) { const int st = (r >> 4) * 2 + (c >> 5), rr = r & 15, cc = c & 31, ob = rr * 64 + cc * 2; return st * 1024 + (ob ^ (((ob >> 9) & 1) << 5)); }
__host__ __device__ __forceinline__ void stage_rc(int b, int& R, int& C) { const int st = b / 1024, sb = b % 1024, swz = sb ^ (((sb >> 9) & 1) << 5); R = (st >> 1) * 16 + swz / 64; C = (st & 1) * 32 + (swz % 64) / 2; }
__host__ __device__ __forceinline__ int perm32(int rho) { const int n = rho >> 4, i = rho & 15; return 8 * (i >> 2) + 4 * n + (i & 3); }

struct Unit { int pm, pn; };
struct Gemm { const bf16_t* A; const bf16_t* Bt; int M, N, K; };

struct StaticOrder {
    int nM, nN, nwg, G, c;
    __host__ __device__ void init(int M, int N, int G_, int c_) { nM = M / BM; nN = N / BM; nwg = nM * nN; G = G_; c = c_; }
    __host__ __device__ bool next(int i, Unit& u) const {
        const long L = (long)i * G + c; if (L >= nwg) return false;
        int wgid = (int)L; { const int q = nwg / NXCD, r = nwg % NXCD, xcd = wgid % NXCD, off = wgid / NXCD; wgid = (xcd < r ? xcd * (q + 1) : r * (q + 1) + (xcd - r) * q) + off; }
        const int nig = WGM * nN, gid = wgid / nig, fm = gid * WGM, gsz = (nM - fm) < WGM ? (nM - fm) : WGM;
        u.pm = fm + ((wgid % nig) % gsz); u.pn = (wgid % nig) / gsz; return true;
    }
    __device__ __forceinline__ void a_ready(const Unit&) const {}
    __device__ __forceinline__ void done(const Unit&) const {}
};

__device__ __forceinline__ unsigned cvt_pk_bf16(float lo, float hi) { unsigned r; asm volatile("v_cvt_pk_bf16_f32 %0, %1, %2" : "=v"(r) : "v"(lo), "v"(hi)); return r; }
typedef float f32x2 __attribute__((ext_vector_type(2)));
__device__ __forceinline__ float silu_f(float v) { return v / (1.f + __expf(-v)); }
__device__ __forceinline__ float logsig_f(float v) { return fminf(v, 0.f) - __logf(1.f + __expf(-fabsf(v))); }

struct EpiProj {
    static constexpr bool PERM = true, AFTER_DRAIN = false;
    bf16_t *QA, *KVA, *QG, *KG, *VG, *GO; float* LA; const float* b_gate;
    __device__ __forceinline__ void operator()(const f32x4 (&acc)[2][2][4][2], const Unit& u, int wr, int wc, int fr, int fq) const {
        const int row0 = u.pm * BM + wr * 64 + fr, ct = wc * 32 + 8 * fq, pn = u.pn;
        if (pn == 9) {
            f32x4 bg[2][2];
#pragma unroll
            for (int bj = 0; bj < 2; ++bj)
#pragma unroll
                for (int n = 0; n < 2; ++n) bg[bj][n] = *(const f32x4*)(b_gate + ct + bj * HALF + 4 * n);
#pragma unroll
            for (int ai = 0; ai < 2; ++ai)
#pragma unroll
                for (int m = 0; m < 4; ++m) { float* rowp = LA + (size_t)(row0 + ai * HALF + m * 16) * 256 + ct;
#pragma unroll
                    for (int bj = 0; bj < 2; ++bj)
#pragma unroll
                        for (int n = 0; n < 2; ++n) { const f32x4 v = acc[ai][bj][m][n] + bg[bj][n]; f32x4 o;
                            o[0] = logsig_f(v[0]) * 0.0625f; o[1] = logsig_f(v[1]) * 0.0625f; o[2] = logsig_f(v[2]) * 0.0625f; o[3] = logsig_f(v[3]) * 0.0625f;
                            *(f32x4*)(rowp + bj * HALF + 4 * n) = o; } }
            return;
        }
        bf16_t* base; int ldc, coff = 0; float sc = 1.f;
        if (pn < 2) { base = QA; ldc = 512; coff = pn * 256; sc = 0.125f * 1.4426950408889634f; }
        else if (pn == 2) { base = KVA; ldc = 256; }
        else if (pn == 3) { base = QG; ldc = 256; sc = 0.125f; }
        else if (pn == 4) { base = KG; ldc = 256; }
        else if (pn < 7) { base = VG; ldc = 512; coff = (pn - 5) * 256; }
        else { base = GO; ldc = 512; coff = (pn - 7) * 256; }
        const bool act = pn >= 7;
#pragma unroll
        for (int ai = 0; ai < 2; ++ai)
#pragma unroll
            for (int m = 0; m < 4; ++m) { bf16_t* rowp = base + (size_t)(row0 + ai * HALF + m * 16) * ldc + coff + ct;
#pragma unroll
                for (int bj = 0; bj < 2; ++bj) { f32x4 v0 = acc[ai][bj][m][0], v1 = acc[ai][bj][m][1];
                    if (act) { v0[0] = silu_f(v0[0]); v0[1] = silu_f(v0[1]); v0[2] = silu_f(v0[2]); v0[3] = silu_f(v0[3]); v1[0] = silu_f(v1[0]); v1[1] = silu_f(v1[1]); v1[2] = silu_f(v1[2]); v1[3] = silu_f(v1[3]); }
                    else { v0 = v0 * sc; v1 = v1 * sc; }
                    u32x4 w; w.x = cvt_pk_bf16(v0[0], v0[1]); w.y = cvt_pk_bf16(v0[2], v0[3]); w.z = cvt_pk_bf16(v1[0], v1[1]); w.w = cvt_pk_bf16(v1[2], v1[3]);
                    *(u32x4*)(rowp + bj * HALF) = w; } }
    }
};
struct EpiResid {
    static constexpr bool PERM = false, AFTER_DRAIN = false;
    const float* base; float* out; const float* gate;
    __device__ __forceinline__ void operator()(const f32x4 (&acc)[2][2][4][2], const Unit& u, int wr, int wc, int fr, int fq) const {
        const int row0 = u.pm * BM + wr * 64 + fr, col0 = u.pn * BM + wc * 32 + 4 * fq, b = u.pm >> 5;
        f32x4 gv[2][2];
#pragma unroll
        for (int bj = 0; bj < 2; ++bj)
#pragma unroll
            for (int n = 0; n < 2; ++n) gv[bj][n] = *(const f32x4*)(gate + (size_t)b * 6144 + col0 + bj * HALF + n * 16);
#pragma unroll
        for (int ai = 0; ai < 2; ++ai)
#pragma unroll
            for (int m = 0; m < 4; ++m) { const size_t off = (size_t)(row0 + ai * HALF + m * 16) * 1024 + col0;
#pragma unroll
                for (int bj = 0; bj < 2; ++bj)
#pragma unroll
                    for (int n = 0; n < 2; ++n) { const f32x4 bs = *(const f32x4*)(base + off + bj * HALF + n * 16); *(f32x4*)(out + off + bj * HALF + n * 16) = bs + gv[bj][n] * acc[ai][bj][m][n]; }
                if (m & 1) asm volatile("" ::: "memory"); }
    }
};
struct EpiRelu2 {
    static constexpr bool PERM = true, AFTER_DRAIN = false;
    bf16_t* H;
    __device__ __forceinline__ void operator()(const f32x4 (&acc)[2][2][4][2], const Unit& u, int wr, int wc, int fr, int fq) const {
        const int row0 = u.pm * BM + wr * 64 + fr, col0 = u.pn * BM + wc * 32 + 8 * fq;
#pragma unroll
        for (int ai = 0; ai < 2; ++ai)
#pragma unroll
            for (int m = 0; m < 4; ++m) { bf16_t* rowp = H + (size_t)(row0 + ai * HALF + m * 16) * 4096 + col0;
#pragma unroll
                for (int bj = 0; bj < 2; ++bj) { f32x4 v0 = acc[ai][bj][m][0], v1 = acc[ai][bj][m][1];
                    v0 = __builtin_elementwise_max(v0, (f32x4){0.f, 0.f, 0.f, 0.f}); v1 = __builtin_elementwise_max(v1, (f32x4){0.f, 0.f, 0.f, 0.f}); v0 = v0 * v0; v1 = v1 * v1;
                    u32x4 w; w.x = cvt_pk_bf16(v0[0], v0[1]); w.y = cvt_pk_bf16(v0[2], v0[3]); w.z = cvt_pk_bf16(v1[0], v1[1]); w.w = cvt_pk_bf16(v1[2], v1[3]);
                    *(u32x4*)(rowp + bj * HALF) = w; } }
    }
};

template <class Epi, class Sched, bool ALIGN_EPI = false, bool SP2 = false>
__device__ __forceinline__ void gemm_phase(PG8_LAS unsigned char* lds, const Gemm g, const Sched& S, const Epi& E) {
    const int tid = threadIdx.x, wid = __builtin_amdgcn_readfirstlane(tid >> 6), lane = tid & 63, wr = wid >> 2, wc = wid & 3, fr = lane & 15, fq = lane >> 4;
    const int K = g.K, nt = K / BK;
    unsigned voffA[2], voffB[2];
#pragma unroll
    for (int i = 0; i < 2; ++i) { int R, C; stage_rc(tid * 16 + i * 8192, R, C); const int Rb = Epi::PERM ? ((R & ~31) + perm32(R & 31)) : R;
        voffA[i] = (unsigned)(R * K + C) * 2u; voffB[i] = (unsigned)(Rb * K + C) * 2u; }
    const size_t kstep = (size_t)(BK * 2);
    const size_t hstep = (size_t)HALF * K * 2;
    const size_t tstep = 2 * hstep;
    const unsigned ldsw = (unsigned)wid * 1024u;
    const int aoff = lds_byte(wr * 64 + fr, fq * 8), boff = lds_byte(wc * 32 + fr, fq * 8);
#define PG8_SA(b, h) (((b) * 2 + (h)) * HTB)
#define PG8_SB(b, h) ((4 + (b) * 2 + (h)) * HTB)
#define PG8_STAGE(bufoff, gbase, voff) do { _Pragma("unroll") for (int _i = 0; _i < 2; ++_i) \
        __builtin_amdgcn_global_load_lds((const unsigned*)((const char*)(gbase) + (voff)[_i]), (PG8_LAS unsigned*)(lds + (bufoff) + ldsw + _i * 8192), 16, 0, 0); } while (0)
#define PG8_LDA(dst, b, h) do { _Pragma("unroll") for (int m = 0; m < 4; ++m) _Pragma("unroll") for (int k = 0; k < 2; ++k) dst[m][k] = *(const PG8_LAS bf16x8*)(lds + PG8_SA(b, h) + aoff + m * 2048 + k * 1024); } while (0)
#define PG8_LDB(dst, b, h) do { _Pragma("unroll") for (int n = 0; n < 2; ++n) _Pragma("unroll") for (int k = 0; k < 2; ++k) dst[n][k] = *(const PG8_LAS bf16x8*)(lds + PG8_SB(b, h) + boff + n * 2048 + k * 1024); } while (0)
#define PG8_MMA(ai, bj, At, Bt) do { __builtin_amdgcn_s_setprio(1); _Pragma("unroll") for (int m = 0; m < 4; ++m) _Pragma("unroll") for (int n = 0; n < 2; ++n) _Pragma("unroll") for (int k = 0; k < 2; ++k) \
        acc[ai][bj][m][n] = __builtin_amdgcn_mfma_f32_16x16x32_bf16(Bt[n][k], At[m][k], acc[ai][bj][m][n], 0, 0, 0); __builtin_amdgcn_s_setprio(0); } while (0)
#define PG8_WAIT_V(n) asm volatile("s_waitcnt vmcnt(" #n ")" ::: "memory")
#define PG8_WAIT_L(n) asm volatile("s_waitcnt lgkmcnt(" #n ")" ::: "memory")
#define PG8_BAR __builtin_amdgcn_s_barrier()
#define PG8_SCHED __builtin_amdgcn_sched_barrier(0)
    Unit cur, nxt; int ui = 0;
    if (!S.next(0, cur)) return;
    f32x4 acc[2][2][4][2];
#pragma unroll
    for (int a = 0; a < 2; ++a)
#pragma unroll
        for (int b = 0; b < 2; ++b)
#pragma unroll
            for (int m = 0; m < 4; ++m)
#pragma unroll
                for (int n = 0; n < 2; ++n) acc[a][b][m][n] = (f32x4){0.f, 0.f, 0.f, 0.f};
    bf16x8 At[4][2], B0[2][2], B1[2][2];
    const char* cA = (const char*)g.A + (size_t)cur.pm * tstep; const char* cB = (const char*)g.Bt + (size_t)cur.pn * tstep;
    S.a_ready(cur);
    if constexpr (SP2) {
        PG8_STAGE(PG8_SB(0, 0), cB, voffB); PG8_STAGE(PG8_SB(0, 1), cB + hstep, voffB); PG8_STAGE(PG8_SA(0, 0), cA, voffA); PG8_STAGE(PG8_SA(0, 1), cA + hstep, voffA);
        if (wr == 1) PG8_BAR;
        PG8_WAIT_V(2); PG8_BAR;
        PG8_STAGE(PG8_SB(1, 0), cB + kstep, voffB); PG8_STAGE(PG8_SA(1, 0), cA + kstep, voffA); PG8_STAGE(PG8_SB(1, 1), cB + hstep + kstep, voffB);
        PG8_WAIT_V(6); PG8_BAR;
    } else {
        PG8_STAGE(PG8_SB(0, 0), cB, voffB); PG8_STAGE(PG8_SA(0, 0), cA, voffA); PG8_STAGE(PG8_SB(0, 1), cB + hstep, voffB); PG8_STAGE(PG8_SA(0, 1), cA + hstep, voffA);
        if (wr == 1) PG8_BAR;
        PG8_WAIT_V(4); PG8_BAR;
        PG8_STAGE(PG8_SB(1, 0), cB + kstep, voffB); PG8_STAGE(PG8_SA(1, 0), cA + kstep, voffA); PG8_STAGE(PG8_SB(1, 1), cB + hstep + kstep, voffB);
        PG8_WAIT_V(6); PG8_BAR;
    }
    for (;;) {
        const bool has_next = S.next(ui + 1, nxt);
        const char* nA = has_next ? (const char*)g.A + (size_t)nxt.pm * tstep : cA; const char* nB = has_next ? (const char*)g.Bt + (size_t)nxt.pn * tstep : cB;
        for (int t = 0; t < nt; t += 2) {
            const bool last = (t == nt - 2);
            const char* a1 = cA + (size_t)(t + 1) * kstep;
            const char* a2 = last ? nA : cA + (size_t)(t + 2) * kstep; const char* b2 = last ? nB : cB + (size_t)(t + 2) * kstep;
            const char* a3 = a2 + kstep; const char* b3 = b2 + kstep;
            if (last && has_next) S.a_ready(nxt);
            if constexpr (SP2) {
            PG8_LDB(B0, 0, 0); PG8_LDB(B1, 0, 1); PG8_SCHED; PG8_LDA(At, 0, 0); PG8_STAGE(PG8_SA(1, 1), a1 + hstep, voffA);
            PG8_WAIT_V(8); PG8_WAIT_L(0); PG8_BAR; PG8_MMA(0, 0, At, B0); PG8_MMA(0, 1, At, B1); PG8_BAR; PG8_SCHED;
            PG8_LDA(At, 0, 1); PG8_STAGE(PG8_SB(0, 0), b2, voffB); PG8_STAGE(PG8_SB(0, 1), b2 + hstep, voffB); PG8_STAGE(PG8_SA(0, 0), a2, voffA);
            PG8_WAIT_V(8); PG8_WAIT_L(0); PG8_BAR; PG8_MMA(1, 0, At, B0); PG8_MMA(1, 1, At, B1); PG8_BAR; PG8_SCHED;
            PG8_LDB(B0, 1, 0); PG8_LDB(B1, 1, 1); PG8_SCHED; PG8_LDA(At, 1, 0); PG8_STAGE(PG8_SA(0, 1), a2 + hstep, voffA);
            PG8_WAIT_V(8); PG8_WAIT_L(0); PG8_BAR; PG8_MMA(0, 0, At, B0); PG8_MMA(0, 1, At, B1); PG8_BAR; PG8_SCHED;
            PG8_LDA(At, 1, 1); PG8_STAGE(PG8_SB(1, 0), b3, voffB); PG8_STAGE(PG8_SB(1, 1), b3 + hstep, voffB); PG8_STAGE(PG8_SA(1, 0), a3, voffA);
            PG8_WAIT_V(8); PG8_WAIT_L(0); PG8_BAR; PG8_MMA(1, 0, At, B0); PG8_MMA(1, 1, At, B1); PG8_BAR; PG8_SCHED;
            } else {
            PG8_LDB(B0, 0, 0); PG8_SCHED; PG8_LDA(At, 0, 0); PG8_STAGE(PG8_SA(1, 1), a1 + hstep, voffA);
            PG8_WAIT_L(8); PG8_BAR; PG8_WAIT_L(0); PG8_MMA(0, 0, At, B0); PG8_BAR; PG8_SCHED;
            PG8_LDB(B1, 0, 1); PG8_STAGE(PG8_SB(0, 0), b2, voffB);
            PG8_BAR; PG8_WAIT_L(0); PG8_MMA(0, 1, At, B1); PG8_BAR;
            PG8_LDA(At, 0, 1); PG8_STAGE(PG8_SA(0, 0), a2, voffA);
            PG8_BAR; PG8_WAIT_L(0); PG8_MMA(1, 0, At, B0); PG8_BAR; PG8_SCHED;
            PG8_STAGE(PG8_SB(0, 1), b2 + hstep, voffB);
            PG8_WAIT_V(6); PG8_BAR; PG8_MMA(1, 1, At, B1); PG8_BAR;
            PG8_LDB(B0, 1, 0); PG8_SCHED; PG8_LDA(At, 1, 0); PG8_STAGE(PG8_SA(0, 1), a2 + hstep, voffA);
            PG8_WAIT_L(8); PG8_BAR; PG8_WAIT_L(0); PG8_MMA(0, 0, At, B0); PG8_BAR; PG8_SCHED;
            PG8_LDB(B1, 1, 1); PG8_STAGE(PG8_SB(1, 0), b3, voffB);
            PG8_BAR; PG8_WAIT_L(0); PG8_MMA(0, 1, At, B1); PG8_BAR;
            PG8_LDA(At, 1, 1); PG8_STAGE(PG8_SA(1, 0), a3, voffA);
            PG8_BAR; PG8_WAIT_L(0); PG8_MMA(1, 0, At, B0); PG8_BAR; PG8_SCHED;
            PG8_STAGE(PG8_SB(1, 1), b3 + hstep, voffB);
            PG8_WAIT_V(6); PG8_BAR; PG8_MMA(1, 1, At, B1); PG8_BAR;
            }
        }
        if constexpr (ALIGN_EPI) { if (wr == 0) PG8_BAR; }
        if constexpr (!Epi::AFTER_DRAIN) { E(acc, cur, wr, wc, fr, fq); S.done(cur); }
        if (!has_next) break;
#pragma unroll
        for (int a = 0; a < 2; ++a)
#pragma unroll
            for (int b = 0; b < 2; ++b)
#pragma unroll
                for (int m = 0; m < 4; ++m)
#pragma unroll
                    for (int n = 0; n < 2; ++n) acc[a][b][m][n] = (f32x4){0.f, 0.f, 0.f, 0.f};
        cur = nxt; cA = nA; cB = nB; ++ui;
        if constexpr (ALIGN_EPI) { if (wr == 1) PG8_BAR; }
    }
    PG8_WAIT_V(0);
    if constexpr (!ALIGN_EPI) { if (wr == 0) PG8_BAR; }
    PG8_BAR;
    if constexpr (Epi::AFTER_DRAIN) { E.fused(acc, cur, wr, wc, fr, fq, lds, wid, lane); S.done(cur); }
#undef PG8_SA
#undef PG8_SB
#undef PG8_STAGE
#undef PG8_LDA
#undef PG8_LDB
#undef PG8_MMA
#undef PG8_WAIT_V
#undef PG8_WAIT_L
#undef PG8_BAR
#undef PG8_SCHED
}
}
#define GAS __attribute__((address_space(1)))
#define LAS __attribute__((address_space(3)))
typedef unsigned short bf16;
typedef unsigned v4u __attribute__((ext_vector_type(4)));
typedef float f32x4 __attribute__((ext_vector_type(4)));
typedef short bf16x8 __attribute__((ext_vector_type(8)));
typedef GAS unsigned gu32;
typedef GAS unsigned long long gu64;
#define RLX_AGENT __ATOMIC_RELAXED, __HIP_MEMORY_SCOPE_AGENT
#define LDS_WAIT() asm volatile("s_waitcnt lgkmcnt(0)" ::: "memory")
#define VM_WAIT() asm volatile("s_waitcnt vmcnt(0)" ::: "memory")
__device__ __forceinline__ unsigned long long rt() { return __builtin_amdgcn_s_memrealtime(); }
__device__ __forceinline__ unsigned f2bf(float f) { unsigned u = __builtin_bit_cast(unsigned, f); return (u + 0x7fffu + ((u >> 16) & 1u)) >> 16; }
__device__ __forceinline__ unsigned pk2(float lo, float hi) { return f2bf(lo) | (f2bf(hi) << 16); }

#define XB_TMO      128
#define XB_XCNT(j)  (256  + 64 * (j))
#define XB_XSUB(j)  (1280 + 64 * (j))
#define XB_XGEN(j)  (2304 + 64 * (j))
#define XB_TOP      3328
#define XB_TOPGEN   3392
#define XCD_BAR_WORDS 3456
#define XB_SPIN_CAP (1u << 18)

__device__ __forceinline__ unsigned xb_ld(unsigned* p)              { return __hip_atomic_load(p, __ATOMIC_RELAXED, __HIP_MEMORY_SCOPE_AGENT); }
__device__ __forceinline__ unsigned xb_add(unsigned* p, unsigned v) { return __hip_atomic_fetch_add(p, v, __ATOMIC_RELAXED, __HIP_MEMORY_SCOPE_AGENT); }
__device__ __forceinline__ unsigned xb_xcc_id() { return (unsigned)__builtin_amdgcn_s_getreg((3 << 11) | 20) & 0xFu; }
#define XB_SPIN(cond, bar) do { unsigned _sp = 0; while (cond) { __builtin_amdgcn_s_sleep(1); \
    if ((++_sp & 255u) == 0u) { if (xb_ld(&(bar)[XB_TMO])) break; if (_sp > XB_SPIN_CAP) { atomicAdd(&(bar)[XB_TMO], 1u); break; } } } } while (0)

struct XcdBarrier {
    unsigned* bar; unsigned x;
    volatile LAS unsigned* st;
};

__device__ __forceinline__ XcdBarrier xcd_barrier_post(unsigned* bar, volatile LAS unsigned* st) {
    XcdBarrier b; b.bar = bar; b.x = xb_xcc_id(); b.st = st;
    if (threadIdx.x == 0) (void)xb_add(&bar[XB_XCNT(b.x)], 1u);
    return b;
}
__device__ __forceinline__ void xcd_barrier_complete(unsigned* bar, unsigned x, unsigned& nloc, unsigned& nx) {
    const unsigned G = gridDim.x * gridDim.y * gridDim.z;
    unsigned sum, cnt, mine, sp = 0u;
    for (;;) {
        sum = 0u; cnt = 0u; mine = 0u;
#pragma unroll
        for (unsigned j = 0; j < 16; ++j) { const unsigned c = xb_ld(&bar[XB_XCNT(j)]); sum += c; cnt += (c > 0u) ? 1u : 0u; mine = (j == x) ? c : mine; }
        if (sum == G) break;
        __builtin_amdgcn_s_sleep(1);
        if ((++sp & 255u) == 0u) { if (xb_ld(&bar[XB_TMO])) break; if (sp > XB_SPIN_CAP) { atomicAdd(&bar[XB_TMO], 1u); break; } }
    }
    nloc = mine > 0u ? mine : 1u; nx = cnt > 0u ? cnt : 1u;
}

__device__ __forceinline__ void xcd_barrier(const XcdBarrier& b) {
    asm volatile("s_waitcnt vmcnt(0)" ::: "memory");
    __syncthreads();
    if (threadIdx.x == 0) {
        unsigned* bar = b.bar;
        __builtin_amdgcn_s_waitcnt(0);
        unsigned nloc = b.st[0], nx = b.st[1];
        if (nloc == 0u) { xcd_barrier_complete(bar, b.x, nloc, nx); b.st[0] = nloc; b.st[1] = nx; }
        const unsigned old = xb_add(&bar[XB_XSUB(b.x)], 1u);
        const unsigned gen = old / nloc;
        if (old + 1u == (gen + 1u) * nloc) {
            __builtin_amdgcn_fence(__ATOMIC_RELEASE, "agent");
            asm volatile("s_waitcnt vmcnt(0)" ::: "memory");
            const unsigned og = xb_add(&bar[XB_TOP], 1u);
            const unsigned tg = og / nx;
            if (og + 1u == (tg + 1u) * nx) xb_add(&bar[XB_TOPGEN], 1u);
            else XB_SPIN(xb_ld(&bar[XB_TOPGEN]) == tg, bar);
            __builtin_amdgcn_fence(__ATOMIC_ACQUIRE, "agent");
            xb_add(&bar[XB_XGEN(b.x)], 1u);
            asm volatile("s_waitcnt vmcnt(0)" ::: "memory");
        } else {
            XB_SPIN(xb_ld(&bar[XB_XGEN(b.x)]) == gen, bar);
            __builtin_amdgcn_fence(__ATOMIC_ACQUIRE, "agent");
            asm volatile("s_waitcnt vmcnt(0)" ::: "memory");
        }
    }
    __syncthreads();
}

__device__ __forceinline__ float bf2f(unsigned short h) { return __uint_as_float((unsigned)h << 16); }
__device__ __forceinline__ float wave_sum(float v) {
#pragma unroll
    for (int o = 1; o < 64; o <<= 1) v += __shfl_xor(v, o);
    return v;
}
__device__ __forceinline__ void unpack8(const v4u w, float* f) {
    f[0] = __uint_as_float(w.x << 16); f[1] = __uint_as_float(w.x & 0xffff0000u); f[2] = __uint_as_float(w.y << 16); f[3] = __uint_as_float(w.y & 0xffff0000u);
    f[4] = __uint_as_float(w.z << 16); f[5] = __uint_as_float(w.z & 0xffff0000u); f[6] = __uint_as_float(w.w << 16); f[7] = __uint_as_float(w.w & 0xffff0000u);
}

struct Params { const float* in[14]; float* out; unsigned char* ws; int ph_lo, ph_hi; };
struct Ctx { LAS unsigned char* lds; int tid, lane, wave, gw, ngw; };

__device__ __forceinline__ void transpose_item(const float* W, int ldw, int nblk, int K, bf16* WT, LAS float* scr, int item, int lane) {
    const int kb = item / nblk, nb = item % nblk, k0 = 64 * kb, n0 = 32 * nb;
#pragma unroll 8
    for (int i = 0; i < 32; ++i) { const int kk = 2 * i + (lane >> 5); scr[kk * 33 + (lane & 31)] = W[(size_t)(k0 + kk) * ldw + n0 + (lane & 31)]; }
    LDS_WAIT(); asm volatile("" ::: "memory");
    const int c = lane & 7;
#pragma unroll
    for (int j = 0; j < 4; ++j) { const int n = (lane >> 3) + 8 * j; const LAS float* s = scr + (8 * c) * 33 + n;
        v4u o; o.x = pk2(s[0 * 33], s[1 * 33]); o.y = pk2(s[2 * 33], s[3 * 33]); o.z = pk2(s[4 * 33], s[5 * 33]); o.w = pk2(s[6 * 33], s[7 * 33]);
        *(GAS v4u*)(WT + (size_t)(n0 + n) * K + k0 + 8 * c) = o; }
    LDS_WAIT(); asm volatile("" ::: "memory");
}
__device__ __forceinline__ void p0_prologue(const Ctx& C, const Params& P) {
    LAS float* scr = (LAS float*)(C.lds + C.wave * 16384);
    unsigned char* ws = P.ws;
    const float* cin = P.in[1]; const float* w_ada = P.in[2]; const float* b_ada = P.in[3]; const float* w_in = P.in[4]; const float* wgu = P.in[5];
    float* ADA = (float*)(ws + WS_ADA);
    bf16* WIN = (bf16*)(ws + WS_WIN);
    constexpr int I_ADA = 96 * 8, I_IN = 16 * 72, I_OUT = 16 * 32, I_1 = 16 * 128, I_2 = 64 * 32, I_Z = 256 * 16;
    constexpr int NITEMS = I_ADA + I_IN + I_OUT + I_1 + I_2 + I_Z;
    for (int it = C.gw; it < NITEMS; it += C.ngw) {
        int r = it; const int lane = C.lane;
        if (r < I_ADA) {
            const int cgi = r >> 3, ks = r & 7, n = cgi * 64 + lane, k0 = ks * 128;
#pragma unroll
            for (int i = 0; i < 16; ++i) { const int idx = i * 64 + lane, b = idx >> 7, k = idx & 127; const float cv = cin[b * 1024 + k0 + k]; scr[k * 8 + b] = cv / (1.f + __expf(-cv)); }
            LDS_WAIT(); asm volatile("" ::: "memory");
            float a[8];
#pragma unroll
            for (int b = 0; b < 8; ++b) a[b] = 0.f;
#pragma unroll 4
            for (int k = 0; k < 128; ++k) { const float w = w_ada[(size_t)(k0 + k) * 6144 + n]; const f32x4 c0 = *(const LAS f32x4*)(scr + k * 8), c1 = *(const LAS f32x4*)(scr + k * 8 + 4);
                a[0] += c0[0] * w; a[1] += c0[1] * w; a[2] += c0[2] * w; a[3] += c0[3] * w; a[4] += c1[0] * w; a[5] += c1[1] * w; a[6] += c1[2] * w; a[7] += c1[3] * w; }
            const float bb = (ks == 0) ? b_ada[n] : 0.f;
#pragma unroll
            for (int b = 0; b < 8; ++b) atomicAdd(ADA + b * 6144 + n, a[b] + bb);
            LDS_WAIT(); asm volatile("" ::: "memory");
            continue; }
        r -= I_ADA;
        if (r < I_IN) { transpose_item(w_in, DIN, 72, D, WIN, scr, r, lane); continue; } r -= I_IN;
        if (r < I_OUT) { transpose_item(P.in[10], D, 32, D, (bf16*)(ws + WS_WOUT), scr, r, lane); continue; } r -= I_OUT;
        if (r < I_1) { transpose_item(P.in[11], FF, 128, D, (bf16*)(ws + WS_W1), scr, r, lane); continue; } r -= I_1;
        if (r < I_2) { transpose_item(P.in[12], D, 32, FF, (bf16*)(ws + WS_W2), scr, r, lane); continue; } r -= I_2;
        {
            const int n = r >> 4, k = (r & 15) * 64 + lane; const float* wr = w_in + (size_t)k * DIN + 2304; float acc = 0.f;
#pragma unroll
            for (int q = 0; q < 4; ++q) { const f32x4 wv = *(const f32x4*)(wr + 4 * q);
                acc += wv[0] * wgu[(4 * q + 0) * 256 + n] + wv[1] * wgu[(4 * q + 1) * 256 + n] + wv[2] * wgu[(4 * q + 2) * 256 + n] + wv[3] * wgu[(4 * q + 3) * 256 + n]; }
            WIN[(size_t)(2304 + n) * D + k] = (bf16)f2bf(acc);
        }
    }
}

__device__ __forceinline__ void xn_pass(const Ctx& C, const float* src, const float* ADA, int shift_off, int scale_off, bf16* XN) {
    for (int m = C.gw; m < M; m += C.ngw) {
        const GAS f32x4* xr = (const GAS f32x4*)(src + (size_t)m * D) + C.lane;
        f32x4 v[4]; float s = 0.f;
#pragma unroll
        for (int j = 0; j < 4; ++j) { v[j] = xr[64 * j]; s += (v[j].x * v[j].x + v[j].y * v[j].y) + (v[j].z * v[j].z + v[j].w * v[j].w); }
        const float rstd = 1.f / sqrtf(wave_sum(s) * (1.f / D) + EPS);
        const int b = m >> 13;
        const f32x4* sc = (const f32x4*)(ADA + b * 6144 + scale_off) + C.lane; const f32x4* sh = (const f32x4*)(ADA + b * 6144 + shift_off) + C.lane;
        GAS unsigned long long* o8 = (GAS unsigned long long*)(XN + (size_t)m * D) + C.lane;
#pragma unroll
        for (int j = 0; j < 4; ++j) { const f32x4 a = sc[64 * j], h = sh[64 * j]; const f32x4 o = v[j] * rstd * (a + 1.f) + h;
            o8[64 * j] = (unsigned long long)pk2(o.x, o.y) | ((unsigned long long)pk2(o.z, o.w) << 32); }
    }
}
__device__ __forceinline__ void final_norm_pass(const Ctx& C, float* xo, const float* g) {
    for (int m = C.gw; m < M; m += C.ngw) {
        GAS f32x4* xr = (GAS f32x4*)(xo + (size_t)m * D) + C.lane;
        f32x4 v[4]; float s = 0.f;
#pragma unroll
        for (int j = 0; j < 4; ++j) { v[j] = xr[64 * j]; s += (v[j].x * v[j].x + v[j].y * v[j].y) + (v[j].z * v[j].z + v[j].w * v[j].w); }
        const float rstd = 1.f / sqrtf(wave_sum(s) * (1.f / D) + EPS);
        const f32x4* gg = (const f32x4*)g + C.lane;
#pragma unroll
        for (int j = 0; j < 4; ++j) xr[64 * j] = v[j] * rstd * gg[64 * j];
    }
}

__device__ __forceinline__ void swa_naive_phase(const Ctx& C, const Params& P) {
    float* Ks = (float*)((unsigned char*)C.lds);
    LAS float* KsL = (LAS float*)C.lds; LAS float* VsL = KsL + 256 * 68; LAS float* BtL = VsL + 256 * 68;
    (void)Ks;
    const bf16* QA = (const bf16*)(P.ws + WS_QA); const bf16* KVA = (const bf16*)(P.ws + WS_KVA); bf16* MIX = (bf16*)(P.ws + WS_MIX);
    const float* sinks = P.in[8]; const float* rel_bias = P.in[9];
    const int t = C.tid;
    for (int unit = blockIdx.x; unit < 1024; unit += gridDim.x) {
        const int b = unit >> 7, kvh = (unit >> 6) & 1, nb = unit & 63;
        __syncthreads();
        { const int row = t >> 1, half = t & 1, pos = (nb - 1) * 128 + row;
          float kf[32], vf[32];
          if (pos >= 0) { const bf16* src = KVA + (size_t)(b * T + pos) * 256 + kvh * 64 + half * 32;
#pragma unroll
              for (int i = 0; i < 4; ++i) { unpack8(*(const v4u*)(src + 8 * i), kf + 8 * i); unpack8(*(const v4u*)(src + 128 + 8 * i), vf + 8 * i); } }
          else {
#pragma unroll
              for (int i = 0; i < 32; ++i) { kf[i] = 0.f; vf[i] = 0.f; } }
#pragma unroll
          for (int i = 0; i < 8; ++i) { *(LAS f32x4*)(KsL + row * 68 + half * 32 + 4 * i) = (f32x4){kf[4 * i], kf[4 * i + 1], kf[4 * i + 2], kf[4 * i + 3]};
                                        *(LAS f32x4*)(VsL + row * 68 + half * 32 + 4 * i) = (f32x4){vf[4 * i], vf[4 * i + 1], vf[4 * i + 2], vf[4 * i + 3]}; }
          const int g = t >> 7, dist = t & 127;
          BtL[t] = rel_bias[(int)T5_BUCKET[dist] * 8 + kvh * 4 + g] * LOG2E; }
        __syncthreads();
        const int g = t >> 7, i = t & 127, head = kvh * 4 + g; const size_t rowq = (size_t)b * T + nb * 128 + i;
        float q[64], o[64];
        { const bf16* qs = QA + rowq * 512 + head * 64;
#pragma unroll
          for (int k = 0; k < 8; ++k) unpack8(*(const v4u*)(qs + 8 * k), q + 8 * k); }
#pragma unroll
        for (int d = 0; d < 64; ++d) o[d] = 0.f;
        float mx = sinks[head] * LOG2E, l = 1.f;
        for (int dd = 0; dd < 128; ++dd) {
            const int j = i + 1 + dd;
            if (nb == 0 && j < 128) continue;
            float s = BtL[g * 128 + 127 - dd];
            const LAS float* kr = KsL + j * 68; const LAS float* vr = VsL + j * 68;
#pragma unroll
            for (int d = 0; d < 64; d += 4) { const f32x4 kv = *(const LAS f32x4*)(kr + d); s += q[d] * kv[0] + q[d + 1] * kv[1] + q[d + 2] * kv[2] + q[d + 3] * kv[3]; }
            const float mn = fmaxf(mx, s), cc = exp2f(mx - mn), p = exp2f(s - mn);
            l = l * cc + p; mx = mn;
#pragma unroll
            for (int d = 0; d < 64; d += 4) { const f32x4 vv = *(const LAS f32x4*)(vr + d); o[d] = o[d] * cc + p * vv[0]; o[d + 1] = o[d + 1] * cc + p * vv[1]; o[d + 2] = o[d + 2] * cc + p * vv[2]; o[d + 3] = o[d + 3] * cc + p * vv[3]; }
        }
        const float inv = 1.f / l;
        bf16* op = MIX + rowq * 1024 + head * 64;
#pragma unroll
        for (int k = 0; k < 8; ++k) { v4u w; w.x = pk2(o[8 * k] * inv, o[8 * k + 1] * inv); w.y = pk2(o[8 * k + 2] * inv, o[8 * k + 3] * inv); w.z = pk2(o[8 * k + 4] * inv, o[8 * k + 5] * inv); w.w = pk2(o[8 * k + 6] * inv, o[8 * k + 7] * inv);
            *(v4u*)(op + 8 * k) = w; }
    }
}

template <bool OUT> __device__ __forceinline__ void gla_naive_phase(const Ctx& C, const Params& P) {
    const int sub = C.tid >> 7, e = C.tid & 127;
    LAS float* R = (LAS float*)C.lds + sub * 7296;
    LAS float* Al = R, *Kl = R + 1024, *Ql = R + 2048, *Vl = R + 3072, *Ol = R + 5120, *Ll = R + 7168;
    const bf16* QG = (const bf16*)(P.ws + WS_QG); const bf16* KG = (const bf16*)(P.ws + WS_KG); const bf16* VG = (const bf16*)(P.ws + WS_VG); const bf16* GO = (const bf16*)(P.ws + WS_GO);
    const float* LA = (const float*)(P.ws + WS_LA); float* SLOC = (float*)(P.ws + WS_SLOC); float* ECUM = (float*)(P.ws + WS_ECUM); bf16* MIX = (bf16*)(P.ws + WS_MIX);
    const float* gng = P.in[7];
    for (int grp = blockIdx.x; grp < 128; grp += gridDim.x) {
        const int u = grp * 4 + sub, bh = u >> 4, j = u & 15, b = bh >> 2, h = bh & 3;
        const size_t tok0 = (size_t)b * T + j * 512;
        float S[64];
#pragma unroll
        for (int d = 0; d < 64; ++d) S[d] = 0.f;
        if (OUT) {
            for (int i = 0; i < j; ++i) { const int ui = bh * 16 + i;
#pragma unroll
                for (int d = 0; d < 64; ++d) S[d] = ECUM[ui * 64 + d] * S[d] + SLOC[((size_t)ui * 64 + d) * 128 + e]; }
        }
        float lsum = 0.f;
        for (int tb = 0; tb < 32; ++tb) {
            __syncthreads();
            { const int d = e & 63;
#pragma unroll
              for (int q = 0; q < 8; ++q) { const int r = (e >> 6) + 2 * q; const size_t tok = tok0 + tb * 16 + r;
                  const float la = LA[tok * 256 + h * 64 + d]; lsum += la; Al[r * 64 + d] = __expf(la);
                  Kl[r * 64 + d] = bf2f(KG[tok * 256 + h * 64 + d]);
                  if (OUT) Ql[r * 64 + d] = bf2f(QG[tok * 256 + h * 64 + d]); }
#pragma unroll
              for (int r = 0; r < 16; ++r) { const size_t tok = tok0 + tb * 16 + r; Vl[r * 128 + e] = bf2f(VG[tok * 512 + h * 128 + e]); } }
            __syncthreads();
            for (int r = 0; r < 16; ++r) {
                const float vt = Vl[r * 128 + e]; float o = 0.f;
#pragma unroll
                for (int d = 0; d < 64; d += 4) { const f32x4 a4 = *(const LAS f32x4*)(Al + r * 64 + d), k4 = *(const LAS f32x4*)(Kl + r * 64 + d);
                    S[d] = a4[0] * S[d] + k4[0] * vt; S[d + 1] = a4[1] * S[d + 1] + k4[1] * vt; S[d + 2] = a4[2] * S[d + 2] + k4[2] * vt; S[d + 3] = a4[3] * S[d + 3] + k4[3] * vt;
                    if (OUT) { const f32x4 q4 = *(const LAS f32x4*)(Ql + r * 64 + d); o += q4[0] * S[d] + q4[1] * S[d + 1] + q4[2] * S[d + 2] + q4[3] * S[d + 3]; } }
                if (OUT) Ol[r * 128 + e] = o;
            }
            if (OUT) {
                __syncthreads();
                const int ws2 = (C.tid >> 6) & 1, lane = C.lane;
                for (int rr = 0; rr < 8; ++rr) { const int r = ws2 * 8 + rr; const size_t tok = tok0 + tb * 16 + r;
                    const float x0 = Ol[r * 128 + lane], x1 = Ol[r * 128 + 64 + lane];
                    const float ss = wave_sum(x0 * x0 + x1 * x1); const float rn = 1.f / sqrtf(ss * (1.f / 128.f) + EPS);
                    const float g0 = bf2f(GO[tok * 512 + h * 128 + lane]), g1 = bf2f(GO[tok * 512 + h * 128 + 64 + lane]);
                    MIX[tok * 1024 + 512 + h * 128 + lane] = (bf16)f2bf(x0 * rn * gng[lane] * g0);
                    MIX[tok * 1024 + 512 + h * 128 + 64 + lane] = (bf16)f2bf(x1 * rn * gng[64 + lane] * g1); }
            }
        }
        if (!OUT) {
#pragma unroll
            for (int d = 0; d < 64; ++d) SLOC[((size_t)u * 64 + d) * 128 + e] = S[d];
            __syncthreads();
            Ll[e] = lsum;
            __syncthreads();
            if (e < 64) ECUM[u * 64 + e] = __expf(Ll[e] + Ll[e + 64]);
        }
    }
}

__global__ void __launch_bounds__(512, 2) fwd_kernel(Params P) {
    extern __shared__ __attribute__((aligned(16))) unsigned char lds[];
    cg::grid_group grid = cg::this_grid();
    Ctx C; C.lds = (LAS unsigned char*)lds; C.tid = threadIdx.x; C.lane = C.tid & 63; C.wave = __builtin_amdgcn_readfirstlane(C.tid >> 6);
    C.gw = blockIdx.x * 8 + C.wave; C.ngw = gridDim.x * 8;
    unsigned char* ws = P.ws;
    const float* ADA = (const float*)(ws + WS_ADA);
    bf16* XN = (bf16*)(ws + WS_XN);
    const int lo = P.ph_lo, hi = P.ph_hi;
#define IN(k) (lo <= (k) && (k) < hi)
#define SEAM(k) do { if (IN(k) && IN((k) + 1)) grid.sync(); } while (0)

    if (IN(0)) p0_prologue(C, P);
    SEAM(0);
    if (IN(1)) xn_pass(C, P.in[0], ADA, 0, 1024, XN);
    SEAM(1);
    if (IN(2)) {
        pg8::Gemm g{XN, (const bf16*)(ws + WS_WIN), M, NPROJ, D}; pg8::StaticOrder S; S.init(M, NPROJ, gridDim.x, (int)blockIdx.x);
        pg8::EpiProj E{(bf16*)(ws + WS_QA), (bf16*)(ws + WS_KVA), (bf16*)(ws + WS_QG), (bf16*)(ws + WS_KG), (bf16*)(ws + WS_VG), (bf16*)(ws + WS_GO), (float*)(ws + WS_LA), P.in[6]};
        pg8::gemm_phase<pg8::EpiProj, pg8::StaticOrder, true, true>(C.lds, g, S, E);
    }
    SEAM(2);
    if (IN(3)) { swa_naive_phase(C, P); __syncthreads(); gla_naive_phase<false>(C, P); }
    SEAM(3);
    if (IN(4)) gla_naive_phase<true>(C, P);
    SEAM(4);
    if (IN(5)) {
        pg8::Gemm g{(const bf16*)(ws + WS_MIX), (const bf16*)(ws + WS_WOUT), M, D, D}; pg8::StaticOrder S; S.init(M, D, gridDim.x, (int)blockIdx.x);
        pg8::EpiResid E{P.in[0], P.out, ADA + 2048};
        pg8::gemm_phase<pg8::EpiResid, pg8::StaticOrder, true, true>(C.lds, g, S, E);
    }
    SEAM(5);
    if (IN(6)) xn_pass(C, P.out, ADA, 3072, 4096, XN);
    SEAM(6);
    if (IN(7)) {
        pg8::Gemm g{XN, (const bf16*)(ws + WS_W1), M, FF, D}; pg8::StaticOrder S; S.init(M, FF, gridDim.x, (int)blockIdx.x);
        pg8::EpiRelu2 E{(bf16*)(ws + WS_H)};
        pg8::gemm_phase<pg8::EpiRelu2, pg8::StaticOrder, true, true>(C.lds, g, S, E);
    }
    SEAM(7);
    if (IN(8)) {
        pg8::Gemm g{(const bf16*)(ws + WS_H), (const bf16*)(ws + WS_W2), M, D, FF}; pg8::StaticOrder S; S.init(M, D, gridDim.x, (int)blockIdx.x);
        pg8::EpiResid E{P.out, P.out, ADA + 5120};
        pg8::gemm_phase<pg8::EpiResid, pg8::StaticOrder, true, true>(C.lds, g, S, E);
    }
    SEAM(8);
    if (IN(9)) final_norm_pass(C, P.out, P.in[13]);
#undef IN
#undef SEAM
}

extern "C" void kernel_launch(void* const* d_in, const int* in_sizes, int n_in, void* d_out, int out_size, void* d_ws, size_t ws_size, hipStream_t stream) {
    static int grid = 0;
    if (grid == 0) {
        if (n_in != 14 || in_sizes[0] != M * D || out_size != M * D || ws_size < WS_END) { fprintf(stderr, "kernel_launch: unexpected shapes: n_in %d in0 %d out %d ws %zu\n", n_in, n_in > 0 ? in_sizes[0] : -1, out_size, ws_size); grid = -1; return; }
        int dev = 0, cus = 0, per_cu = 0;
        if (hipGetDevice(&dev) != hipSuccess || hipDeviceGetAttribute(&cus, hipDeviceAttributeMultiprocessorCount, dev) != hipSuccess) { fprintf(stderr, "kernel_launch: device query failed\n"); grid = -1; return; }
        if (hipFuncSetAttribute((const void*)fwd_kernel, hipFuncAttributeMaxDynamicSharedMemorySize, LDS_BYTES) != hipSuccess) { fprintf(stderr, "kernel_launch: hipFuncSetAttribute failed\n"); grid = -1; return; }
        if (hipOccupancyMaxActiveBlocksPerMultiprocessor(&per_cu, (const void*)fwd_kernel, 512, LDS_BYTES) != hipSuccess || per_cu < 1) { fprintf(stderr, "kernel_launch: occupancy query says %d blocks per CU\n", per_cu); (void)hipGetLastError(); grid = -1; return; }
        grid = cus;
    }
    if (grid < 0) return;
    if (hipMemsetAsync((char*)d_ws + WS_CTL, 0, CTL_ZERO_BYTES, stream) != hipSuccess) { fprintf(stderr, "kernel_launch: memset failed\n"); return; }
    Params p{};
    for (int i = 0; i < 14; ++i) p.in[i] = (const float*)d_in[i];
    p.out = (float*)d_out; p.ws = (unsigned char*)d_ws;
    constexpr int NL = MK_N_LAUNCHES;
    for (int li = 0; li < NL; ++li) {
        if (NL == 1) { p.ph_lo = 0; p.ph_hi = NPHASE; } else { p.ph_lo = li; p.ph_hi = li + 1; }
        void* args[] = {&p};
        const hipError_t e = hipLaunchCooperativeKernel((const void*)fwd_kernel, dim3(grid), dim3(512), args, LDS_BYTES, stream);
        if (e != hipSuccess) { fprintf(stderr, "kernel_launch: cooperative launch %d failed: %s (grid %d)\n", li, hipGetErrorString(e), grid); break; }
    }
}
```

```cpp
#include <hip/hip_runtime.h>
#include <hip/hip_cooperative_groups.h>
#include <cstdio>
#include <cstdint>
namespace cg = cooperative_groups;

#ifndef SWA_MFMA
#define SWA_MFMA 1
#endif
#ifndef GLA_MFMA
#define GLA_MFMA 1
#endif
#ifndef MK_N_LAUNCHES
#define MK_N_LAUNCHES 1
#endif

constexpr int BATCH = 8, T = 8192, D = 1024, M = BATCH * T, FF = 4096;
constexpr int NPROJ = 2560;
constexpr int DIN = 2320;
constexpr float EPS = 1e-6f;
constexpr float LOG2E = 1.4426950408889634f;
constexpr int NPHASE = 10;

constexpr size_t MiB = 1u << 20;
constexpr size_t WS_CTL = 0, CTL_ZERO_BYTES = 1 * MiB;
constexpr size_t WS_ADA = 512 * 1024;
constexpr size_t WS_WIN = 2 * MiB, WS_WOUT = 8 * MiB, WS_W1 = 10 * MiB, WS_W2 = 18 * MiB;
constexpr size_t WS_SLOC = 32 * MiB, WS_ECUM = 48 * MiB;
constexpr size_t WS_XN = 64 * MiB;
constexpr size_t WS_QA = 192 * MiB, WS_KVA = 256 * MiB, WS_QG = 288 * MiB, WS_KG = 320 * MiB, WS_VG = 352 * MiB, WS_GO = 416 * MiB, WS_LA = 480 * MiB, WS_MIX = 544 * MiB;
constexpr size_t WS_H = 192 * MiB;
constexpr size_t WS_END = 704 * MiB;

constexpr int LDS_BYTES = 147456;

__constant__ unsigned char T5_BUCKET[128] = {0, 1, 2, 3, 4, 5, 6, 7, 8, 9, 10, 11, 12, 13, 14, 15, 16, 16, 16, 17, 17, 18, 18, 18, 19, 19, 19, 20, 20, 20, 20, 21, 21, 21, 21, 22, 22, 22, 22, 22, 23, 23, 23, 23, 23, 23, 24, 24, 24, 24, 24, 24, 25, 25, 25, 25, 25, 25, 25, 26, 26, 26, 26, 26, 26, 26, 26, 27, 27, 27, 27, 27, 27, 27, 27, 27, 27, 28, 28, 28, 28, 28, 28, 28, 28, 28, 28, 29, 29, 29, 29, 29, 29, 29, 29, 29, 29, 29, 29, 30, 30, 30, 30, 30, 30, 30, 30, 30, 30, 30, 30, 30, 30, 31, 31, 31, 31, 31, 31, 31, 31, 31, 31, 31, 31, 31, 31, 31};

namespace pg8 {
#define PG8_LAS __attribute__((address_space(3)))
typedef unsigned short bf16_t;
typedef short bf16x8 __attribute__((ext_vector_type(8)));
typedef float f32x4 __attribute__((ext_vector_type(4)));
typedef unsigned u32x4 __attribute__((ext_vector_type(4)));
constexpr int BM = 256, BK = 64, HALF = 128, HTB = HALF * BK * 2  , STAGE_BYTES = 8 * HTB, NXCD = 8, WGM = 8;

__host__ __device__ __forceinline__ int lds_byte(int r, int c) { const int st = (r >> 4) * 2 + (c >> 5), rr = r & 15, cc = c & 31, ob = rr * 64 + cc * 2; return st * 1024 + (ob ^ (((ob >> 9) & 1) << 5)); }
__host__ __device__ __forceinline__ void stage_rc(int b, int& R, int& C) { const int st = b / 1024, sb = b % 1024, swz = sb ^ (((sb >> 9) & 1) << 5); R = (st >> 1) * 16 + swz / 64; C = (st & 1) * 32 + (swz % 64) / 2; }
__host__ __device__ __forceinline__ int perm32(int rho) { const int n = rho >> 4, i = rho & 15; return 8 * (i >> 2) + 4 * n + (i & 3); }

struct Unit { int pm, pn; };
struct Gemm { const bf16_t* A; const bf16_t* Bt; int M, N, K; };

struct StaticOrder {
    int nM, nN, nwg, G, c;
    __host__ __device__ void init(int M, int N, int G_, int c_) { nM = M / BM; nN = N / BM; nwg = nM * nN; G = G_; c = c_; }
    __host__ __device__ bool next(int i, Unit& u) const {
        const long L = (long)i * G + c; if (L >= nwg) return false;
        int wgid = (int)L; { const int q = nwg / NXCD, r = nwg % NXCD, xcd = wgid % NXCD, off = wgid / NXCD; wgid = (xcd < r ? xcd * (q + 1) : r * (q + 1) + (xcd - r) * q) + off; }
        const int nig = WGM * nN, gid = wgid / nig, fm = gid * WGM, gsz = (nM - fm) < WGM ? (nM - fm) : WGM;
        u.pm = fm + ((wgid % nig) % gsz); u.pn = (wgid % nig) / gsz; return true;
    }
    __device__ __forceinline__ void a_ready(const Unit&) const {}
    __device__ __forceinline__ void done(const Unit&) const {}
};

__device__ __forceinline__ unsigned cvt_pk_bf16(float lo, float hi) { unsigned r; asm volatile("v_cvt_pk_bf16_f32 %0, %1, %2" : "=v"(r) : "v"(lo), "v"(hi)); return r; }
typedef float f32x2 __attribute__((ext_vector_type(2)));
__device__ __forceinline__ float silu_f(float v) { return v / (1.f + __expf(-v)); }
__device__ __forceinline__ float logsig_f(float v) { return fminf(v, 0.f) - __logf(1.f + __expf(-fabsf(v))); }

struct EpiProj {
    static constexpr bool PERM = true, AFTER_DRAIN = false;
    bf16_t *QA, *KVA, *QG, *KG, *VG, *GO; float* LA; const float* b_gate;
    __device__ __forceinline__ void operator()(const f32x4 (&acc)[2][2][4][2], const Unit& u, int wr, int wc, int fr, int fq) const {
        const int row0 = u.pm * BM + wr * 64 + fr, ct = wc * 32 + 8 * fq, pn = u.pn;
        if (pn == 9) {
            f32x4 bg[2][2];
#pragma unroll
            for (int bj = 0; bj < 2; ++bj)
#pragma unroll
                for (int n = 0; n < 2; ++n) bg[bj][n] = *(const f32x4*)(b_gate + ct + bj * HALF + 4 * n);
#pragma unroll
            for (int ai = 0; ai < 2; ++ai)
#pragma unroll
                for (int m = 0; m < 4; ++m) { float* rowp = LA + (size_t)(row0 + ai * HALF + m * 16) * 256 + ct;
#pragma unroll
                    for (int bj = 0; bj < 2; ++bj)
#pragma unroll
                        for (int n = 0; n < 2; ++n) { const f32x4 v = acc[ai][bj][m][n] + bg[bj][n]; f32x4 o;
                            o[0] = logsig_f(v[0]) * 0.0625f; o[1] = logsig_f(v[1]) * 0.0625f; o[2] = logsig_f(v[2]) * 0.0625f; o[3] = logsig_f(v[3]) * 0.0625f;
                            *(f32x4*)(rowp + bj * HALF + 4 * n) = o; } }
            return;
        }
        bf16_t* base; int ldc, coff = 0; float sc = 1.f;
        if (pn < 2) { base = QA; ldc = 512; coff = pn * 256; sc = 0.125f * 1.4426950408889634f; }
        else if (pn == 2) { base = KVA; ldc = 256; }
        else if (pn == 3) { base = QG; ldc = 256; sc = 0.125f; }
        else if (pn == 4) { base = KG; ldc = 256; }
        else if (pn < 7) { base = VG; ldc = 512; coff = (pn - 5) * 256; }
        else { base = GO; ldc = 512; coff = (pn - 7) * 256; }
        const bool act = pn >= 7;
#pragma unroll
        for (int ai = 0; ai < 2; ++ai)
#pragma unroll
            for (int m = 0; m < 4; ++m) { bf16_t* rowp = base + (size_t)(row0 + ai * HALF + m * 16) * ldc + coff + ct;
#pragma unroll
                for (int bj = 0; bj < 2; ++bj) { f32x4 v0 = acc[ai][bj][m][0], v1 = acc[ai][bj][m][1];
                    if (act) { v0[0] = silu_f(v0[0]); v0[1] = silu_f(v0[1]); v0[2] = silu_f(v0[2]); v0[3] = silu_f(v0[3]); v1[0] = silu_f(v1[0]); v1[1] = silu_f(v1[1]); v1[2] = silu_f(v1[2]); v1[3] = silu_f(v1[3]); }
                    else { v0 = v0 * sc; v1 = v1 * sc; }
                    u32x4 w; w.x = cvt_pk_bf16(v0[0], v0[1]); w.y = cvt_pk_bf16(v0[2], v0[3]); w.z = cvt_pk_bf16(v1[0], v1[1]); w.w = cvt_pk_bf16(v1[2], v1[3]);
                    *(u32x4*)(rowp + bj * HALF) = w; } }
    }
};
struct EpiResid {
    static constexpr bool PERM = false, AFTER_DRAIN = false;
    const float* base; float* out; const float* gate;
    __device__ __forceinline__ void operator()(const f32x4 (&acc)[2][2][4][2], const Unit& u, int wr, int wc, int fr, int fq) const {
        const int row0 = u.pm * BM + wr * 64 + fr, col0 = u.pn * BM + wc * 32 + 4 * fq, b = u.pm >> 5;
        f32x4 gv[2][2];
#pragma unroll
        for (int bj = 0; bj < 2; ++bj)
#pragma unroll
            for (int n = 0; n < 2; ++n) gv[bj][n] = *(const f32x4*)(gate + (size_t)b * 6144 + col0 + bj * HALF + n * 16);
#pragma unroll
        for (int ai = 0; ai < 2; ++ai)
#pragma unroll
            for (int m = 0; m < 4; ++m) { const size_t off = (size_t)(row0 + ai * HALF + m * 16) * 1024 + col0;
#pragma unroll
                for (int bj = 0; bj < 2; ++bj)
#pragma unroll
                    for (int n = 0; n < 2; ++n) { const f32x4 bs = *(const f32x4*)(base + off + bj * HALF + n * 16); *(f32x4*)(out + off + bj * HALF + n * 16) = bs + gv[bj][n] * acc[ai][bj][m][n]; }
                if (m & 1) asm volatile("" ::: "memory"); }
    }
};
struct EpiRelu2 {
    static constexpr bool PERM = true, AFTER_DRAIN = false;
    bf16_t* H;
    __device__ __forceinline__ void operator()(const f32x4 (&acc)[2][2][4][2], const Unit& u, int wr, int wc, int fr, int fq) const {
        const int row0 = u.pm * BM + wr * 64 + fr, col0 = u.pn * BM + wc * 32 + 8 * fq;
#pragma unroll
        for (int ai = 0; ai < 2; ++ai)
#pragma unroll
            for (int m = 0; m < 4; ++m) { bf16_t* rowp = H + (size_t)(row0 + ai * HALF + m * 16) * 4096 + col0;
#pragma unroll
                for (int bj = 0; bj < 2; ++bj) { f32x4 v0 = acc[ai][bj][m][0], v1 = acc[ai][bj][m][1];
                    v0 = __builtin_elementwise_max(v0, (f32x4){0.f, 0.f, 0.f, 0.f}); v1 = __builtin_elementwise_max(v1, (f32x4){0.f, 0.f, 0.f, 0.f}); v0 = v0 * v0; v1 = v1 * v1;
                    u32x4 w; w.x = cvt_pk_bf16(v0[0], v0[1]); w.y = cvt_pk_bf16(v0[2], v0[3]); w.z = cvt_pk_bf16(v1[0], v1[1]); w.w = cvt_pk_bf16(v1[2], v1[3]);
                    *(u32x4*)(rowp + bj * HALF) = w; } }
    }
};

template <class Epi, class Sched, bool ALIGN_EPI = false, bool SP2 = false>
__device__ __forceinline__ void gemm_phase(PG8_LAS unsigned char* lds, const Gemm g, const Sched& S, const Epi& E) {
    const int tid = threadIdx.x, wid = __builtin_amdgcn_readfirstlane(tid >> 6), lane = tid & 63, wr = wid >> 2, wc = wid & 3, fr = lane & 15, fq = lane >> 4;
    const int K = g.K, nt = K / BK;
    unsigned voffA[2], voffB[2];
#pragma unroll
    for (int i = 0; i < 2; ++i) { int R, C; stage_rc(tid * 16 + i * 8192, R, C); const int Rb = Epi::PERM ? ((R & ~31) + perm32(R & 31)) : R;
        voffA[i] = (unsigned)(R * K + C) * 2u; voffB[i] = (unsigned)(Rb * K + C) * 2u; }
    const size_t kstep = (size_t)(BK * 2);
    const size_t hstep = (size_t)HALF * K * 2;
    const size_t tstep = 2 * hstep;
    const unsigned ldsw = (unsigned)wid * 1024u;
    const int aoff = lds_byte(wr * 64 + fr, fq * 8), boff = lds_byte(wc * 32 + fr, fq * 8);
#define PG8_SA(b, h) (((b) * 2 + (h)) * HTB)
#define PG8_SB(b, h) ((4 + (b) * 2 + (h)) * HTB)
#define PG8_STAGE(bufoff, gbase, voff) do { _Pragma("unroll") for (int _i = 0; _i < 2; ++_i) \
        __builtin_amdgcn_global_load_lds((const unsigned*)((const char*)(gbase) + (voff)[_i]), (PG8_LAS unsigned*)(lds + (bufoff) + ldsw + _i * 8192), 16, 0, 0); } while (0)
#define PG8_LDA(dst, b, h) do { _Pragma("unroll") for (int m = 0; m < 4; ++m) _Pragma("unroll") for (int k = 0; k < 2; ++k) dst[m][k] = *(const PG8_LAS bf16x8*)(lds + PG8_SA(b, h) + aoff + m * 2048 + k * 1024); } while (0)
#define PG8_LDB(dst, b, h) do { _Pragma("unroll") for (int n = 0; n < 2; ++n) _Pragma("unroll") for (int k = 0; k < 2; ++k) dst[n][k] = *(const PG8_LAS bf16x8*)(lds + PG8_SB(b, h) + boff + n * 2048 + k * 1024); } while (0)
#define PG8_MMA(ai, bj, At, Bt) do { __builtin_amdgcn_s_setprio(1); _Pragma("unroll") for (int m = 0; m < 4; ++m) _Pragma("unroll") for (int n = 0; n < 2; ++n) _Pragma("unroll") for (int k = 0; k < 2; ++k) \
        acc[ai][bj][m][n] = __builtin_amdgcn_mfma_f32_16x16x32_bf16(Bt[n][k], At[m][k], acc[ai][bj][m][n], 0, 0, 0); __builtin_amdgcn_s_setprio(0); } while (0)
#define PG8_WAIT_V(n) asm volatile("s_waitcnt vmcnt(" #n ")" ::: "memory")
#define PG8_WAIT_L(n) asm volatile("s_waitcnt lgkmcnt(" #n ")" ::: "memory")
#define PG8_BAR __builtin_amdgcn_s_barrier()
#define PG8_SCHED __builtin_amdgcn_sched_barrier(0)
    Unit cur, nxt; int ui = 0;
    if (!S.next(0, cur)) return;
    f32x4 acc[2][2][4][2];
#pragma unroll
    for (int a = 0; a < 2; ++a)
#pragma unroll
        for (int b = 0; b < 2; ++b)
#pragma unroll
            for (int m = 0; m < 4; ++m)
#pragma unroll
                for (int n = 0; n < 2; ++n) acc[a][b][m][n] = (f32x4){0.f, 0.f, 0.f, 0.f};
    bf16x8 At[4][2], B0[2][2], B1[2][2];
    const char* cA = (const char*)g.A + (size_t)cur.pm * tstep; const char* cB = (const char*)g.Bt + (size_t)cur.pn * tstep;
    S.a_ready(cur);
    if constexpr (SP2) {
        PG8_STAGE(PG8_SB(0, 0), cB, voffB); PG8_STAGE(PG8_SB(0, 1), cB + hstep, voffB); PG8_STAGE(PG8_SA(0, 0), cA, voffA); PG8_STAGE(PG8_SA(0, 1), cA + hstep, voffA);
        if (wr == 1) PG8_BAR;
        PG8_WAIT_V(2); PG8_BAR;
        PG8_STAGE(PG8_SB(1, 0), cB + kstep, voffB); PG8_STAGE(PG8_SA(1, 0), cA + kstep, voffA); PG8_STAGE(PG8_SB(1, 1), cB + hstep + kstep, voffB);
        PG8_WAIT_V(6); PG8_BAR;
    } else {
        PG8_STAGE(PG8_SB(0, 0), cB, voffB); PG8_STAGE(PG8_SA(0, 0), cA, voffA); PG8_STAGE(PG8_SB(0, 1), cB + hstep, voffB); PG8_STAGE(PG8_SA(0, 1), cA + hstep, voffA);
        if (wr == 1) PG8_BAR;
        PG8_WAIT_V(4); PG8_BAR;
        PG8_STAGE(PG8_SB(1, 0), cB + kstep, voffB); PG8_STAGE(PG8_SA(1, 0), cA + kstep, voffA); PG8_STAGE(PG8_SB(1, 1), cB + hstep + kstep, voffB);
        PG8_WAIT_V(6); PG8_BAR;
    }
    for (;;) {
        const bool has_next = S.next(ui + 1, nxt);
        const char* nA = has_next ? (const char*)g.A + (size_t)nxt.pm * tstep : cA; const char* nB = has_next ? (const char*)g.Bt + (size_t)nxt.pn * tstep : cB;
        for (int t = 0; t < nt; t += 2) {
            const bool last = (t == nt - 2);
            const char* a1 = cA + (size_t)(t + 1) * kstep;
            const char* a2 = last ? nA : cA + (size_t)(t + 2) * kstep; const char* b2 = last ? nB : cB + (size_t)(t + 2) * kstep;
            const char* a3 = a2 + kstep; const char* b3 = b2 + kstep;
            if (last && has_next) S.a_ready(nxt);
            if constexpr (SP2) {
            PG8_LDB(B0, 0, 0); PG8_LDB(B1, 0, 1); PG8_SCHED; PG8_LDA(At, 0, 0); PG8_STAGE(PG8_SA(1, 1), a1 + hstep, voffA);
            PG8_WAIT_V(8); PG8_WAIT_L(0); PG8_BAR; PG8_MMA(0, 0, At, B0); PG8_MMA(0, 1, At, B1); PG8_BAR; PG8_SCHED;
            PG8_LDA(At, 0, 1); PG8_STAGE(PG8_SB(0, 0), b2, voffB); PG8_STAGE(PG8_SB(0, 1), b2 + hstep, voffB); PG8_STAGE(PG8_SA(0, 0), a2, voffA);
            PG8_WAIT_V(8); PG8_WAIT_L(0); PG8_BAR; PG8_MMA(1, 0, At, B0); PG8_MMA(1, 1, At, B1); PG8_BAR; PG8_SCHED;
            PG8_LDB(B0, 1, 0); PG8_LDB(B1, 1, 1); PG8_SCHED; PG8_LDA(At, 1, 0); PG8_STAGE(PG8_SA(0, 1), a2 + hstep, voffA);
            PG8_WAIT_V(8); PG8_WAIT_L(0); PG8_BAR; PG8_MMA(0, 0, At, B0); PG8_MMA(0, 1, At, B1); PG8_BAR; PG8_SCHED;
            PG8_LDA(At, 1, 1); PG8_STAGE(PG8_SB(1, 0), b3, voffB); PG8_STAGE(PG8_SB(1, 1), b3 + hstep, voffB); PG8_STAGE(PG8_SA(1, 0), a3, voffA);
            PG8_WAIT_V(8); PG8_WAIT_L(0); PG8_BAR; PG8_MMA(1, 0, At, B0); PG8_MMA(1, 1, At, B1); PG8_BAR; PG8_SCHED;
            } else {
            PG8_LDB(B0, 0, 0); PG8_SCHED; PG8_LDA(At, 0, 0); PG8_STAGE(PG8_SA(1, 1), a1 + hstep, voffA);
            PG8_WAIT_L(8); PG8_BAR; PG8_WAIT_L(0); PG8_MMA(0, 0, At, B0); PG8_BAR; PG8_SCHED;
            PG8_LDB(B1, 0, 1); PG8_STAGE(PG8_SB(0, 0), b2, voffB);
            PG8_BAR; PG8_WAIT_L(0); PG8_MMA(0, 1, At, B1); PG8_BAR;
            PG8_LDA(At, 0, 1); PG8_STAGE(PG8_SA(0, 0), a2, voffA);
            PG8_BAR; PG8_WAIT_L(0); PG8_MMA(1, 0, At, B0); PG8_BAR; PG8_SCHED;
            PG8_STAGE(PG8_SB(0, 1), b2 + hstep, voffB);
            PG8_WAIT_V(6); PG8_BAR; PG8_MMA(1, 1, At, B1); PG8_BAR;
            PG8_LDB(B0, 1, 0); PG8_SCHED; PG8_LDA(At, 1, 0); PG8_STAGE(PG8_SA(0, 1), a2 + hstep, voffA);
            PG8_WAIT_L(8); PG8_BAR; PG8_WAIT_L(0); PG8_MMA(0, 0, At, B0); PG8_BAR; PG8_SCHED;
            PG8_LDB(B1, 1, 1); PG8_STAGE(PG8_SB(1, 0), b3, voffB);
            PG8_BAR; PG8_WAIT_L(0); PG8_MMA(0, 1, At, B1); PG8_BAR;
            PG8_LDA(At, 1, 1); PG8_STAGE(PG8_SA(1, 0), a3, voffA);
            PG8_BAR; PG8_WAIT_L(0); PG8_MMA(1, 0, At, B0); PG8_BAR; PG8_SCHED;
            PG8_STAGE(PG8_SB(1, 1), b3 + hstep, voffB);
            PG8_WAIT_V(6); PG8_BAR; PG8_MMA(1, 1, At, B1); PG8_BAR;
            }
        }
        if constexpr (ALIGN_EPI) { if (wr == 0) PG8_BAR; }
        if constexpr (!Epi::AFTER_DRAIN) { E(acc, cur, wr, wc, fr, fq); S.done(cur); }
        if (!has_next) break;
#pragma unroll
        for (int a = 0; a < 2; ++a)
#pragma unroll
            for (int b = 0; b < 2; ++b)
#pragma unroll
                for (int m = 0; m < 4; ++m)
#pragma unroll
                    for (int n = 0; n < 2; ++n) acc[a][b][m][n] = (f32x4){0.f, 0.f, 0.f, 0.f};
        cur = nxt; cA = nA; cB = nB; ++ui;
        if constexpr (ALIGN_EPI) { if (wr == 1) PG8_BAR; }
    }
    PG8_WAIT_V(0);
    if constexpr (!ALIGN_EPI) { if (wr == 0) PG8_BAR; }
    PG8_BAR;
    if constexpr (Epi::AFTER_DRAIN) { E.fused(acc, cur, wr, wc, fr, fq, lds, wid, lane); S.done(cur); }
#undef PG8_SA
#undef PG8_SB
#undef PG8_STAGE
#undef PG8_LDA
#undef PG8_LDB
#undef PG8_MMA
#undef PG8_WAIT_V
#undef PG8_WAIT_L
#undef PG8_BAR
#undef PG8_SCHED
}
}
#define GAS __attribute__((address_space(1)))
#define LAS __attribute__((address_space(3)))
typedef unsigned short bf16;
typedef unsigned v4u __attribute__((ext_vector_type(4)));
typedef float f32x4 __attribute__((ext_vector_type(4)));
typedef short bf16x8 __attribute__((ext_vector_type(8)));
typedef GAS unsigned gu32;
typedef GAS unsigned long long gu64;
#define RLX_AGENT __ATOMIC_RELAXED, __HIP_MEMORY_SCOPE_AGENT
#define LDS_WAIT() asm volatile("s_waitcnt lgkmcnt(0)" ::: "memory")
#define VM_WAIT() asm volatile("s_waitcnt vmcnt(0)" ::: "memory")
__device__ __forceinline__ unsigned long long rt() { return __builtin_amdgcn_s_memrealtime(); }
__device__ __forceinline__ unsigned f2bf(float f) { unsigned u = __builtin_bit_cast(unsigned, f); return (u + 0x7fffu + ((u >> 16) & 1u)) >> 16; }
__device__ __forceinline__ unsigned pk2(float lo, float hi) { return f2bf(lo) | (f2bf(hi) << 16); }

#define XB_TMO      128
#define XB_XCNT(j)  (256  + 64 * (j))
#define XB_XSUB(j)  (1280 + 64 * (j))
#define XB_XGEN(j)  (2304 + 64 * (j))
#define XB_TOP      3328
#define XB_TOPGEN   3392
#define XCD_BAR_WORDS 3456
#define XB_SPIN_CAP (1u << 18)

__device__ __forceinline__ unsigned xb_ld(unsigned* p)              { return __hip_atomic_load(p, __ATOMIC_RELAXED, __HIP_MEMORY_SCOPE_AGENT); }
__device__ __forceinline__ unsigned xb_add(unsigned* p, unsigned v) { return __hip_atomic_fetch_add(p, v, __ATOMIC_RELAXED, __HIP_MEMORY_SCOPE_AGENT); }
__device__ __forceinline__ unsigned xb_xcc_id() { return (unsigned)__builtin_amdgcn_s_getreg((3 << 11) | 20) & 0xFu; }
#define XB_SPIN(cond, bar) do { unsigned _sp = 0; while (cond) { __builtin_amdgcn_s_sleep(1); \
    if ((++_sp & 255u) == 0u) { if (xb_ld(&(bar)[XB_TMO])) break; if (_sp > XB_SPIN_CAP) { atomicAdd(&(bar)[XB_TMO], 1u); break; } } } } while (0)

struct XcdBarrier {
    unsigned* bar; unsigned x;
    volatile LAS unsigned* st;
};

__device__ __forceinline__ XcdBarrier xcd_barrier_post(unsigned* bar, volatile LAS unsigned* st) {
    XcdBarrier b; b.bar = bar; b.x = xb_xcc_id(); b.st = st;
    if (threadIdx.x == 0) (void)xb_add(&bar[XB_XCNT(b.x)], 1u);
    return b;
}
__device__ __forceinline__ void xcd_barrier_complete(unsigned* bar, unsigned x, unsigned& nloc, unsigned& nx) {
    const unsigned G = gridDim.x * gridDim.y * gridDim.z;
    unsigned sum, cnt, mine, sp = 0u;
    for (;;) {
        sum = 0u; cnt = 0u; mine = 0u;
#pragma unroll
        for (unsigned j = 0; j < 16; ++j) { const unsigned c = xb_ld(&bar[XB_XCNT(j)]); sum += c; cnt += (c > 0u) ? 1u : 0u; mine = (j == x) ? c : mine; }
        if (sum == G) break;
        __builtin_amdgcn_s_sleep(1);
        if ((++sp & 255u) == 0u) { if (xb_ld(&bar[XB_TMO])) break; if (sp > XB_SPIN_CAP) { atomicAdd(&bar[XB_TMO], 1u); break; } }
    }
    nloc = mine > 0u ? mine : 1u; nx = cnt > 0u ? cnt : 1u;
}

__device__ __forceinline__ void xcd_barrier(const XcdBarrier& b) {
    asm volatile("s_waitcnt vmcnt(0)" ::: "memory");
    __syncthreads();
    if (threadIdx.x == 0) {
        unsigned* bar = b.bar;
        __builtin_amdgcn_s_waitcnt(0);
        unsigned nloc = b.st[0], nx = b.st[1];
        if (nloc == 0u) { xcd_barrier_complete(bar, b.x, nloc, nx); b.st[0] = nloc; b.st[1] = nx; }
        const unsigned old = xb_add(&bar[XB_XSUB(b.x)], 1u);
        const unsigned gen = old / nloc;
        if (old + 1u == (gen + 1u) * nloc) {
            __builtin_amdgcn_fence(__ATOMIC_RELEASE, "agent");
            asm volatile("s_waitcnt vmcnt(0)" ::: "memory");
            const unsigned og = xb_add(&bar[XB_TOP], 1u);
            const unsigned tg = og / nx;
            if (og + 1u == (tg + 1u) * nx) xb_add(&bar[XB_TOPGEN], 1u);
            else XB_SPIN(xb_ld(&bar[XB_TOPGEN]) == tg, bar);
            __builtin_amdgcn_fence(__ATOMIC_ACQUIRE, "agent");
            xb_add(&bar[XB_XGEN(b.x)], 1u);
            asm volatile("s_waitcnt vmcnt(0)" ::: "memory");
        } else {
            XB_SPIN(xb_ld(&bar[XB_XGEN(b.x)]) == gen, bar);
            __builtin_amdgcn_fence(__ATOMIC_ACQUIRE, "agent");
            asm volatile("s_waitcnt vmcnt(0)" ::: "memory");
        }
    }
    __syncthreads();
}

__device__ __forceinline__ float bf2f(unsigned short h) { return __uint_as_float((unsigned)h << 16); }
__device__ __forceinline__ float wave_sum(float v) {
#pragma unroll
    for (int o = 1; o < 64; o <<= 1) v += __shfl_xor(v, o);
    return v;
}
__device__ __forceinline__ void unpack8(const v4u w, float* f) {
    f[0] = __uint_as_float(w.x << 16); f[1] = __uint_as_float(w.x & 0xffff0000u); f[2] = __uint_as_float(w.y << 16); f[3] = __uint_as_float(w.y & 0xffff0000u);
    f[4] = __uint_as_float(w.z << 16); f[5] = __uint_as_float(w.z & 0xffff0000u); f[6] = __uint_as_float(w.w << 16); f[7] = __uint_as_float(w.w & 0xffff0000u);
}

struct Params { const float* in[14]; float* out; unsigned char* ws; int ph_lo, ph_hi; };
struct Ctx { LAS unsigned char* lds; int tid, lane, wave, gw, ngw; };

__device__ __forceinline__ void transpose_item(const float* W, int ldw, int nblk, int K, bf16* WT, LAS float* scr, int item, int lane) {
    const int kb = item / nblk, nb = item % nblk, k0 = 64 * kb, n0 = 32 * nb;
#pragma unroll 8
    for (int i = 0; i < 32; ++i) { const int kk = 2 * i + (lane >> 5); scr[kk * 33 + (lane & 31)] = W[(size_t)(k0 + kk) * ldw + n0 + (lane & 31)]; }
    LDS_WAIT(); asm volatile("" ::: "memory");
    const int c = lane & 7;
#pragma unroll
    for (int j = 0; j < 4; ++j) { const int n = (lane >> 3) + 8 * j; const LAS float* s = scr + (8 * c) * 33 + n;
        v4u o; o.x = pk2(s[0 * 33], s[1 * 33]); o.y = pk2(s[2 * 33], s[3 * 33]); o.z = pk2(s[4 * 33], s[5 * 33]); o.w = pk2(s[6 * 33], s[7 * 33]);
        *(GAS v4u*)(WT + (size_t)(n0 + n) * K + k0 + 8 * c) = o; }
    LDS_WAIT(); asm volatile("" ::: "memory");
}
__device__ __forceinline__ void p0_prologue(const Ctx& C, const Params& P) {
    LAS float* scr = (LAS float*)(C.lds + C.wave * 16384);
    unsigned char* ws = P.ws;
    const float* cin = P.in[1]; const float* w_ada = P.in[2]; const float* b_ada = P.in[3]; const float* w_in = P.in[4]; const float* wgu = P.in[5];
    float* ADA = (float*)(ws + WS_ADA);
    bf16* WIN = (bf16*)(ws + WS_WIN);
    constexpr int I_ADA = 96 * 8, I_IN = 16 * 72, I_OUT = 16 * 32, I_1 = 16 * 128, I_2 = 64 * 32, I_Z = 256 * 16;
    constexpr int NITEMS = I_ADA + I_IN + I_OUT + I_1 + I_2 + I_Z;
    for (int it = C.gw; it < NITEMS; it += C.ngw) {
        int r = it; const int lane = C.lane;
        if (r < I_ADA) {
            const int cgi = r >> 3, ks = r & 7, n = cgi * 64 + lane, k0 = ks * 128;
#pragma unroll
            for (int i = 0; i < 16; ++i) { const int idx = i * 64 + lane, b = idx >> 7, k = idx & 127; const float cv = cin[b * 1024 + k0 + k]; scr[k * 8 + b] = cv / (1.f + __expf(-cv)); }
            LDS_WAIT(); asm volatile("" ::: "memory");
            float a[8];
#pragma unroll
            for (int b = 0; b < 8; ++b) a[b] = 0.f;
#pragma unroll 4
            for (int k = 0; k < 128; ++k) { const float w = w_ada[(size_t)(k0 + k) * 6144 + n]; const f32x4 c0 = *(const LAS f32x4*)(scr + k * 8), c1 = *(const LAS f32x4*)(scr + k * 8 + 4);
                a[0] += c0[0] * w; a[1] += c0[1] * w; a[2] += c0[2] * w; a[3] += c0[3] * w; a[4] += c1[0] * w; a[5] += c1[1] * w; a[6] += c1[2] * w; a[7] += c1[3] * w; }
            const float bb = (ks == 0) ? b_ada[n] : 0.f;
#pragma unroll
            for (int b = 0; b < 8; ++b) atomicAdd(ADA + b * 6144 + n, a[b] + bb);
            LDS_WAIT(); asm volatile("" ::: "memory");
            continue; }
        r -= I_ADA;
        if (r < I_IN) { transpose_item(w_in, DIN, 72, D, WIN, scr, r, lane); continue; } r -= I_IN;
        if (r < I_OUT) { transpose_item(P.in[10], D, 32, D, (bf16*)(ws + WS_WOUT), scr, r, lane); continue; } r -= I_OUT;
        if (r < I_1) { transpose_item(P.in[11], FF, 128, D, (bf16*)(ws + WS_W1), scr, r, lane); continue; } r -= I_1;
        if (r < I_2) { transpose_item(P.in[12], D, 32, FF, (bf16*)(ws + WS_W2), scr, r, lane); continue; } r -= I_2;
        {
            const int n = r >> 4, k = (r & 15) * 64 + lane; const float* wr = w_in + (size_t)k * DIN + 2304; float acc = 0.f;
#pragma unroll
            for (int q = 0; q < 4; ++q) { const f32x4 wv = *(const f32x4*)(wr + 4 * q);
                acc += wv[0] * wgu[(4 * q + 0) * 256 + n] + wv[1] * wgu[(4 * q + 1) * 256 + n] + wv[2] * wgu[(4 * q + 2) * 256 + n] + wv[3] * wgu[(4 * q + 3) * 256 + n]; }
            WIN[(size_t)(2304 + n) * D + k] = (bf16)f2bf(acc);
        }
    }
}

__device__ __forceinline__ void xn_pass(const Ctx& C, const float* src, const float* ADA, int shift_off, int scale_off, bf16* XN) {
    for (int m = C.gw; m < M; m += C.ngw) {
        const GAS f32x4* xr = (const GAS f32x4*)(src + (size_t)m * D) + C.lane;
        f32x4 v[4]; float s = 0.f;
#pragma unroll
        for (int j = 0; j < 4; ++j) { v[j] = xr[64 * j]; s += (v[j].x * v[j].x + v[j].y * v[j].y) + (v[j].z * v[j].z + v[j].w * v[j].w); }
        const float rstd = 1.f / sqrtf(wave_sum(s) * (1.f / D) + EPS);
        const int b = m >> 13;
        const f32x4* sc = (const f32x4*)(ADA + b * 6144 + scale_off) + C.lane; const f32x4* sh = (const f32x4*)(ADA + b * 6144 + shift_off) + C.lane;
        GAS unsigned long long* o8 = (GAS unsigned long long*)(XN + (size_t)m * D) + C.lane;
#pragma unroll
        for (int j = 0; j < 4; ++j) { const f32x4 a = sc[64 * j], h = sh[64 * j]; const f32x4 o = v[j] * rstd * (a + 1.f) + h;
            o8[64 * j] = (unsigned long long)pk2(o.x, o.y) | ((unsigned long long)pk2(o.z, o.w) << 32); }
    }
}
__device__ __forceinline__ void final_norm_pass(const Ctx& C, float* xo, const float* g) {
    for (int m = C.gw; m < M; m += C.ngw) {
        GAS f32x4* xr = (GAS f32x4*)(xo + (size_t)m * D) + C.lane;
        f32x4 v[4]; float s = 0.f;
#pragma unroll
        for (int j = 0; j < 4; ++j) { v[j] = xr[64 * j]; s += (v[j].x * v[j].x + v[j].y * v[j].y) + (v[j].z * v[j].z + v[j].w * v[j].w); }
        const float rstd = 1.f / sqrtf(wave_sum(s) * (1.f / D) + EPS);
        const f32x4* gg = (const f32x4*)g + C.lane;
#pragma unroll
        for (int j = 0; j < 4; ++j) xr[64 * j] = v[j] * rstd * gg[64 * j];
    }
}

__device__ __forceinline__ void swa_naive_phase(const Ctx& C, const Params& P) {
    LAS float* KsL = (LAS float*)C.lds; LAS float* VsL = KsL + 256 * 68; LAS float* BtL = VsL + 256 * 68;
    const bf16* QA = (const bf16*)(P.ws + WS_QA); const bf16* KVA = (const bf16*)(P.ws + WS_KVA); bf16* MIX = (bf16*)(P.ws + WS_MIX);
    const float* sinks = P.in[8]; const float* rel_bias = P.in[9];
    const int t = C.tid;
    for (int unit = blockIdx.x; unit < 1024; unit += gridDim.x) {
        const int b = unit >> 7, kvh = (unit >> 6) & 1, nb = unit & 63;
        __syncthreads();
        { const int row = t >> 1, half = t & 1, pos = (nb - 1) * 128 + row;
          float kf[32], vf[32];
          if (pos >= 0) { const bf16* src = KVA + (size_t)(b * T + pos) * 256 + kvh * 64 + half * 32;
#pragma unroll
              for (int i = 0; i < 4; ++i) { unpack8(*(const v4u*)(src + 8 * i), kf + 8 * i); unpack8(*(const v4u*)(src + 128 + 8 * i), vf + 8 * i); } }
          else {
#pragma unroll
              for (int i = 0; i < 32; ++i) { kf[i] = 0.f; vf[i] = 0.f; } }
#pragma unroll
          for (int i = 0; i < 8; ++i) { *(LAS f32x4*)(KsL + row * 68 + half * 32 + 4 * i) = (f32x4){kf[4 * i], kf[4 * i + 1], kf[4 * i + 2], kf[4 * i + 3]};
                                        *(LAS f32x4*)(VsL + row * 68 + half * 32 + 4 * i) = (f32x4){vf[4 * i], vf[4 * i + 1], vf[4 * i + 2], vf[4 * i + 3]}; }
          const int g = t >> 7, dist = t & 127;
          BtL[t] = rel_bias[(int)T5_BUCKET[dist] * 8 + kvh * 4 + g] * LOG2E; }
        __syncthreads();
        const int g = t >> 7, i = t & 127, head = kvh * 4 + g; const size_t rowq = (size_t)b * T + nb * 128 + i;
        float q[64], o[64];
        { const bf16* qs = QA + rowq * 512 + head * 64;
#pragma unroll
          for (int k = 0; k < 8; ++k) unpack8(*(const v4u*)(qs + 8 * k), q + 8 * k); }
#pragma unroll
        for (int d = 0; d < 64; ++d) o[d] = 0.f;
        float mx = sinks[head] * LOG2E, l = 1.f;
        for (int dd = 0; dd < 128; ++dd) {
            const int j = i + 1 + dd;
            if (nb == 0 && j < 128) continue;
            float s = BtL[g * 128 + 127 - dd];
            const LAS float* kr = KsL + j * 68; const LAS float* vr = VsL + j * 68;
#pragma unroll
            for (int d = 0; d < 64; d += 4) { const f32x4 kv = *(const LAS f32x4*)(kr + d); s += q[d] * kv[0] + q[d + 1] * kv[1] + q[d + 2] * kv[2] + q[d + 3] * kv[3]; }
            const float mn = fmaxf(mx, s), cc = exp2f(mx - mn), p = exp2f(s - mn);
            l = l * cc + p; mx = mn;
#pragma unroll
            for (int d = 0; d < 64; d += 4) { const f32x4 vv = *(const LAS f32x4*)(vr + d); o[d] = o[d] * cc + p * vv[0]; o[d + 1] = o[d + 1] * cc + p * vv[1]; o[d + 2] = o[d + 2] * cc + p * vv[2]; o[d + 3] = o[d + 3] * cc + p * vv[3]; }
        }
        const float inv = 1.f / l;
        bf16* op = MIX + rowq * 1024 + head * 64;
#pragma unroll
        for (int k = 0; k < 8; ++k) { v4u w; w.x = pk2(o[8 * k] * inv, o[8 * k + 1] * inv); w.y = pk2(o[8 * k + 2] * inv, o[8 * k + 3] * inv); w.z = pk2(o[8 * k + 4] * inv, o[8 * k + 5] * inv); w.w = pk2(o[8 * k + 6] * inv, o[8 * k + 7] * inv);
            *(v4u*)(op + 8 * k) = w; }
    }
}

template <bool OUT> __device__ __forceinline__ void gla_naive_phase(const Ctx& C, const Params& P) {
    const int sub = C.tid >> 7, e = C.tid & 127;
    LAS float* R = (LAS float*)C.lds + sub * 7296;
    LAS float* Al = R, *Kl = R + 1024, *Ql = R + 2048, *Vl = R + 3072, *Ol = R + 5120, *Ll = R + 7168;
    const bf16* QG = (const bf16*)(P.ws + WS_QG); const bf16* KG = (const bf16*)(P.ws + WS_KG); const bf16* VG = (const bf16*)(P.ws + WS_VG); const bf16* GO = (const bf16*)(P.ws + WS_GO);
    const float* LA = (const float*)(P.ws + WS_LA); float* SLOC = (float*)(P.ws + WS_SLOC); float* ECUM = (float*)(P.ws + WS_ECUM); bf16* MIX = (bf16*)(P.ws + WS_MIX);
    const float* gng = P.in[7];
    for (int grp = blockIdx.x; grp < 128; grp += gridDim.x) {
        const int u = grp * 4 + sub, bh = u >> 4, j = u & 15, b = bh >> 2, h = bh & 3;
        const size_t tok0 = (size_t)b * T + j * 512;
        float S[64];
#pragma unroll
        for (int d = 0; d < 64; ++d) S[d] = 0.f;
        if (OUT) {
            for (int i = 0; i < j; ++i) { const int ui = bh * 16 + i;
#pragma unroll
                for (int d = 0; d < 64; ++d) S[d] = ECUM[ui * 64 + d] * S[d] + SLOC[((size_t)ui * 64 + d) * 128 + e]; }
        }
        float lsum = 0.f;
        for (int tb = 0; tb < 32; ++tb) {
            __syncthreads();
            { const int d = e & 63;
#pragma unroll
              for (int q = 0; q < 8; ++q) { const int r = (e >> 6) + 2 * q; const size_t tok = tok0 + tb * 16 + r;
                  const float la = LA[tok * 256 + h * 64 + d]; lsum += la; Al[r * 64 + d] = __expf(la);
                  Kl[r * 64 + d] = bf2f(KG[tok * 256 + h * 64 + d]);
                  if (OUT) Ql[r * 64 + d] = bf2f(QG[tok * 256 + h * 64 + d]); }
#pragma unroll
              for (int r = 0; r < 16; ++r) { const size_t tok = tok0 + tb * 16 + r; Vl[r * 128 + e] = bf2f(VG[tok * 512 + h * 128 + e]); } }
            __syncthreads();
            for (int r = 0; r < 16; ++r) {
                const float vt = Vl[r * 128 + e]; float o = 0.f;
#pragma unroll
                for (int d = 0; d < 64; d += 4) { const f32x4 a4 = *(const LAS f32x4*)(Al + r * 64 + d), k4 = *(const LAS f32x4*)(Kl + r * 64 + d);
                    S[d] = a4[0] * S[d] + k4[0] * vt; S[d + 1] = a4[1] * S[d + 1] + k4[1] * vt; S[d + 2] = a4[2] * S[d + 2] + k4[2] * vt; S[d + 3] = a4[3] * S[d + 3] + k4[3] * vt;
                    if (OUT) { const f32x4 q4 = *(const LAS f32x4*)(Ql + r * 64 + d); o += q4[0] * S[d] + q4[1] * S[d + 1] + q4[2] * S[d + 2] + q4[3] * S[d + 3]; } }
                if (OUT) Ol[r * 128 + e] = o;
            }
            if (OUT) {
                __syncthreads();
                const int ws2 = (C.tid >> 6) & 1, lane = C.lane;
                for (int rr = 0; rr < 8; ++rr) { const int r = ws2 * 8 + rr; const size_t tok = tok0 + tb * 16 + r;
                    const float x0 = Ol[r * 128 + lane], x1 = Ol[r * 128 + 64 + lane];
                    const float ss = wave_sum(x0 * x0 + x1 * x1); const float rn = 1.f / sqrtf(ss * (1.f / 128.f) + EPS);
                    const float g0 = bf2f(GO[tok * 512 + h * 128 + lane]), g1 = bf2f(GO[tok * 512 + h * 128 + 64 + lane]);
                    MIX[tok * 1024 + 512 + h * 128 + lane] = (bf16)f2bf(x0 * rn * gng[lane] * g0);
                    MIX[tok * 1024 + 512 + h * 128 + 64 + lane] = (bf16)f2bf(x1 * rn * gng[64 + lane] * g1); }
            }
        }
        if (!OUT) {
#pragma unroll
            for (int d = 0; d < 64; ++d) SLOC[((size_t)u * 64 + d) * 128 + e] = S[d];
            __syncthreads();
            Ll[e] = lsum;
            __syncthreads();
            if (e < 64) ECUM[u * 64 + e] = __expf(Ll[e] + Ll[e + 64]);
        }
    }
}


typedef float f32x16 __attribute__((ext_vector_type(16)));
typedef float f32x2_t __attribute__((ext_vector_type(2))); typedef __bf16 bf16x2_t __attribute__((ext_vector_type(2)));
typedef unsigned v2u __attribute__((ext_vector_type(2)));
__device__ __forceinline__ unsigned cvtpk(float lo, float hi) { f32x2_t v = {lo, hi}; bf16x2_t b = __builtin_convertvector(v, bf16x2_t); return __builtin_bit_cast(unsigned, b); }
constexpr int SWA_KL = 0, SWA_VT = 36864, SWA_BT = SWA_VT + 33280, SWA_LDS = SWA_BT + 3072;

__device__ __forceinline__ void swa_task(const Ctx& C, const bf16* QA, bf16* MIX, float sink2, int b, int kvh, int nb, int g, int qg) {
    const int lane = C.lane, c = lane & 31, h = lane >> 5, q0 = 32 * qg, head = kvh * 4 + g;
    const size_t rowq = (size_t)b * T + nb * 128 + q0 + c;
    const LAS unsigned char* L = C.lds;
    bf16x8 qf[4];
#pragma unroll
    for (int s = 0; s < 4; ++s) qf[s] = *(const bf16x8*)(QA + rowq * 512 + head * 64 + 16 * s + 8 * h);
    f32x16 S[5];
    const LAS float* bt = (const LAS float*)(L + SWA_BT) + g * 192 + 31 - c + 4 * h;
    float mloc = -INFINITY;
#pragma unroll
    for (int t = 0; t < 5; ++t) {
        const int j0 = q0 + 32 * t;
        if (nb == 0 && j0 < 128) {
#pragma unroll
            for (int r = 0; r < 16; ++r) S[t][r] = -INFINITY;
        } else {
            f32x16 acc;
#pragma unroll
            for (int r = 0; r < 16; ++r) acc[r] = bt[32 * t + (r & 3) + 8 * (r >> 2)];
            const LAS unsigned char* kp = L + SWA_KL + (j0 + c) * 144 + 16 * h;
#pragma unroll
            for (int s = 0; s < 4; ++s) { const bf16x8 kf = *(const LAS bf16x8*)(kp + 32 * s); acc = __builtin_amdgcn_mfma_f32_32x32x16_bf16(kf, qf[s], acc, 0, 0, 0); }
            S[t] = acc;
#pragma unroll
            for (int r = 0; r < 16; ++r) mloc = fmaxf(mloc, acc[r]);
        }
    }
    float m = fmaxf(mloc, __shfl_xor(mloc, 32)); m = fmaxf(m, sink2);
    float ls = 0.f;
    bf16x8 Pb[5][2];
#pragma unroll
    for (int t = 0; t < 5; ++t) {
#pragma unroll
        for (int r = 0; r < 16; ++r) { const float p = __builtin_amdgcn_exp2f(S[t][r] - m); S[t][r] = p; ls += p; }
#pragma unroll
        for (int s = 0; s < 2; ++s) { v4u w; w.x = cvtpk(S[t][8 * s], S[t][8 * s + 1]); w.y = cvtpk(S[t][8 * s + 2], S[t][8 * s + 3]); w.z = cvtpk(S[t][8 * s + 4], S[t][8 * s + 5]); w.w = cvtpk(S[t][8 * s + 6], S[t][8 * s + 7]);
            Pb[t][s] = __builtin_bit_cast(bf16x8, w); }
    }
    ls += __shfl_xor(ls, 32);
    const float inv = 1.f / (ls + __builtin_amdgcn_exp2f(sink2 - m));
    bf16* op = MIX + rowq * 1024 + head * 64 + 4 * h;
#pragma unroll
    for (int db = 0; db < 2; ++db) {
        f32x16 o;
#pragma unroll
        for (int r = 0; r < 16; ++r) o[r] = 0.f;
        const LAS unsigned char* vp = L + SWA_VT + (32 * db + c) * 520 + 2 * q0 + 8 * h;
#pragma unroll
        for (int t = 0; t < 5; ++t)
#pragma unroll
            for (int s = 0; s < 2; ++s) {
                const v2u lo = *(const LAS v2u*)(vp + 64 * t + 32 * s), hi = *(const LAS v2u*)(vp + 64 * t + 32 * s + 16);
                const v4u w = {lo.x, lo.y, hi.x, hi.y};
                o = __builtin_amdgcn_mfma_f32_32x32x16_bf16(__builtin_bit_cast(bf16x8, w), Pb[t][s], o, 0, 0, 0);
            }
#pragma unroll
        for (int rq = 0; rq < 4; ++rq) { v2u w; w.x = cvtpk(o[4 * rq] * inv, o[4 * rq + 1] * inv); w.y = cvtpk(o[4 * rq + 2] * inv, o[4 * rq + 3] * inv);
            *(v2u*)(op + 32 * db + 8 * rq) = w; }
    }
}

__device__ __forceinline__ void swa_mfma_phase(const Ctx& C, const Params& P) {
    const bf16* QA = (const bf16*)(P.ws + WS_QA); const bf16* KVA = (const bf16*)(P.ws + WS_KVA); bf16* MIX = (bf16*)(P.ws + WS_MIX);
    const float* sinks = P.in[8]; const float* rel_bias = P.in[9];
    const int t = C.tid;
    LAS unsigned char* L = C.lds;
    for (int unit = blockIdx.x; unit < 1024; unit += gridDim.x) {
        const int b = unit >> 7, kvh = (unit >> 6) & 1, nb = unit & 63;
        __syncthreads();
#pragma unroll
        for (int i = 0; i < 4; ++i) { const int ch = t + 512 * i, row = ch >> 3, seg = ch & 7, pos = (nb - 1) * 128 + row;
            v4u w = {0u, 0u, 0u, 0u};
            if (pos >= 0) w = *(const v4u*)(KVA + (size_t)(b * T + pos) * 256 + kvh * 64 + seg * 8);
            *(LAS v4u*)(L + SWA_KL + row * 144 + seg * 16) = w; }
#pragma unroll
        for (int i = 0; i < 2; ++i) { const int it = t + 512 * i, kp = it & 127, dg = it >> 7, pos = (nb - 1) * 128 + 2 * kp;
            v4u w0 = {0u, 0u, 0u, 0u}, w1 = {0u, 0u, 0u, 0u};
            if (pos >= 0) { const bf16* src = KVA + (size_t)(b * T + pos) * 256 + 128 + kvh * 64 + dg * 8; w0 = *(const v4u*)src; w1 = *(const v4u*)(src + 256); }
            LAS unsigned* vt = (LAS unsigned*)(L + SWA_VT + (dg * 8) * 520 + 4 * kp);
            vt[0 * 130] = (w0.x & 0xffffu) | (w1.x << 16); vt[1 * 130] = (w0.x >> 16) | (w1.x & 0xffff0000u);
            vt[2 * 130] = (w0.y & 0xffffu) | (w1.y << 16); vt[3 * 130] = (w0.y >> 16) | (w1.y & 0xffff0000u);
            vt[4 * 130] = (w0.z & 0xffffu) | (w1.z << 16); vt[5 * 130] = (w0.z >> 16) | (w1.z & 0xffff0000u);
            vt[6 * 130] = (w0.w & 0xffffu) | (w1.w << 16); vt[7 * 130] = (w0.w >> 16) | (w1.w & 0xffff0000u); }
        for (int x = t; x < 768; x += 512) { const int g = x / 192, xx = x % 192, dist = 159 - xx;
            float v = -INFINITY; if (dist >= 0 && dist < 128) v = rel_bias[(int)T5_BUCKET[dist] * 8 + kvh * 4 + g] * LOG2E;
            ((LAS float*)(L + SWA_BT))[x] = v; }
        __syncthreads();
        const int g = C.wave & 3, qg = C.wave >> 2;
        const float sink2 = sinks[kvh * 4 + g] * LOG2E;
        swa_task(C, QA, MIX, sink2, b, kvh, nb, g, qg);
        swa_task(C, QA, MIX, sink2, b, kvh, nb, g, qg + 2);
    }
}

typedef short bf16x4 __attribute__((ext_vector_type(4)));
constexpr int GL_QT = 0, GL_KT = 9216, GL_KTT = 18432, GL_VT = 27648, GL_EL = 46080, GL_TS = 46336, GL_OB = 48384, GL_LDS = GL_OB + 64 * 132 * 4;
template <bool OUT> __device__ __forceinline__ void gla_mfma_phase(const Ctx& C, const Params& P) {
    const bf16* QG = (const bf16*)(P.ws + WS_QG); const bf16* KG = (const bf16*)(P.ws + WS_KG); const bf16* VG = (const bf16*)(P.ws + WS_VG); const bf16* GO = (const bf16*)(P.ws + WS_GO);
    const float* LA = (const float*)(P.ws + WS_LA); float* SLOC = (float*)(P.ws + WS_SLOC); float* ECUM = (float*)(P.ws + WS_ECUM); bf16* MIX = (bf16*)(P.ws + WS_MIX);
    const float* gng = P.in[7];
    LAS unsigned char* L = C.lds;
    const int t = C.tid, lane = C.lane, w = C.wave, r16 = lane & 15, q = lane >> 4;
    const int ed = t & 63, erg = t >> 6;
    const int vv = t & 127, vjg = t >> 7;
    for (int u = blockIdx.x; u < 512; u += gridDim.x) {
        const int bh = u >> 4, j = u & 15, b = bh >> 2, h = bh & 3;
        const size_t tok0 = (size_t)b * T + j * 512;
        f32x4 S[4];
#pragma unroll
        for (int td = 0; td < 4; ++td) S[td] = (f32x4){0.f, 0.f, 0.f, 0.f};
        if (OUT) {
            for (int i = 0; i < j; ++i) { const int ui = bh * 16 + i;
#pragma unroll
                for (int td = 0; td < 4; ++td)
#pragma unroll
                    for (int rg = 0; rg < 4; ++rg) { const int d = 16 * td + 4 * q + rg; S[td][rg] = ECUM[ui * 64 + d] * S[td][rg] + SLOC[((size_t)ui * 64 + d) * 128 + 16 * w + r16]; } }
        }
        float logdec = 0.f;
        for (int ch = 0; ch < 8; ++ch) {
            const size_t tokc = tok0 + ch * 64;
            float pre[8];
            { const float* lap = LA + (tokc + 8 * erg) * 256 + h * 64 + ed; float a = 0.f;
#pragma unroll
              for (int i = 0; i < 8; ++i) { a += lap[i * 256]; pre[i] = a; } }
            float kraw[8], qraw[8];
            { const bf16* kp = KG + (tokc + 8 * erg) * 256 + h * 64 + ed; const bf16* qp = QG + (tokc + 8 * erg) * 256 + h * 64 + ed;
#pragma unroll
              for (int i = 0; i < 8; ++i) { kraw[i] = bf2f(kp[i * 256]); if (OUT) qraw[i] = bf2f(qp[i * 256]); } }
            unsigned short vraw[16];
            { const bf16* vp = VG + (tokc + 16 * vjg) * 512 + h * 128 + vv;
#pragma unroll
              for (int i = 0; i < 16; ++i) vraw[i] = vp[i * 512]; }
            ((LAS float*)(L + GL_TS))[erg * 64 + ed] = pre[7];
            __syncthreads();
            { float off = 0.f;
#pragma unroll
              for (int g = 0; g < 7; ++g) { const float tv = ((const LAS float*)(L + GL_TS))[g * 64 + ed]; off += (g < erg) ? tv : 0.f; }
              unsigned kt[8];
#pragma unroll
              for (int i = 0; i < 8; ++i) { const float bb = off + pre[i]; const float ep = __expf(bb), em = __expf(-bb);
                  kt[i] = f2bf(kraw[i] * em);
                  if (OUT) { *(LAS unsigned short*)(L + GL_QT + (8 * erg + i) * 144 + 2 * ed) = (unsigned short)f2bf(qraw[i] * ep);
                             *(LAS unsigned short*)(L + GL_KT + (8 * erg + i) * 144 + 2 * ed) = (unsigned short)kt[i]; }
                  if (i == 7 && erg == 7) { ((LAS float*)(L + GL_EL))[ed] = ep; logdec += bb; } }
              v4u kw = {kt[0] | (kt[1] << 16), kt[2] | (kt[3] << 16), kt[4] | (kt[5] << 16), kt[6] | (kt[7] << 16)};
              *(LAS v4u*)(L + GL_KTT + ed * 144 + erg * 16) = kw;
              v4u v0 = {(unsigned)vraw[0] | ((unsigned)vraw[1] << 16), (unsigned)vraw[2] | ((unsigned)vraw[3] << 16), (unsigned)vraw[4] | ((unsigned)vraw[5] << 16), (unsigned)vraw[6] | ((unsigned)vraw[7] << 16)};
              v4u v1 = {(unsigned)vraw[8] | ((unsigned)vraw[9] << 16), (unsigned)vraw[10] | ((unsigned)vraw[11] << 16), (unsigned)vraw[12] | ((unsigned)vraw[13] << 16), (unsigned)vraw[14] | ((unsigned)vraw[15] << 16)};
              *(LAS v4u*)(L + GL_VT + vv * 144 + vjg * 32) = v0; *(LAS v4u*)(L + GL_VT + vv * 144 + vjg * 32 + 16) = v1; }
            __syncthreads();
            if (OUT) {
                bf16x8 kA[4][2], qB[4][2];
#pragma unroll
                for (int x = 0; x < 4; ++x)
#pragma unroll
                    for (int s = 0; s < 2; ++s) { kA[x][s] = *(const LAS bf16x8*)(L + GL_KT + (16 * x + r16) * 144 + 64 * s + 16 * q); qB[x][s] = *(const LAS bf16x8*)(L + GL_QT + (16 * x + r16) * 144 + 64 * s + 16 * q); }
                v2u ATp[4][4];
#pragma unroll
                for (int ti = 0; ti < 4; ++ti)
#pragma unroll
                    for (int tj = 0; tj < 4; ++tj) {
                        if (tj > ti) { ATp[tj][ti] = (v2u){0u, 0u}; continue; }
                        f32x4 a = {0.f, 0.f, 0.f, 0.f};
                        a = __builtin_amdgcn_mfma_f32_16x16x32_bf16(kA[tj][0], qB[ti][0], a, 0, 0, 0);
                        a = __builtin_amdgcn_mfma_f32_16x16x32_bf16(kA[tj][1], qB[ti][1], a, 0, 0, 0);
                        if (tj == ti) {
#pragma unroll
                            for (int rg = 0; rg < 4; ++rg) a[rg] = (4 * q + rg <= r16) ? a[rg] : 0.f; }
                        ATp[tj][ti] = (v2u){cvtpk(a[0], a[1]), cvtpk(a[2], a[3])};
                    }
                const LAS unsigned char* vtp = L + GL_VT + (16 * w + r16) * 144 + 8 * q;
#pragma unroll
                for (int ti = 0; ti < 4; ++ti) {
                    f32x4 o = {0.f, 0.f, 0.f, 0.f};
#pragma unroll
                    for (int sp = 0; sp < 2; ++sp) {
                        if (2 * sp > ti) continue;
                        const v2u lo = *(const LAS v2u*)(vtp + 64 * sp), hi = *(const LAS v2u*)(vtp + 64 * sp + 32);
                        const v4u bw = {lo.x, lo.y, hi.x, hi.y};
                        const v4u aw = {ATp[2 * sp][ti].x, ATp[2 * sp][ti].y, ATp[2 * sp + 1][ti].x, ATp[2 * sp + 1][ti].y};
                        o = __builtin_amdgcn_mfma_f32_16x16x32_bf16(__builtin_bit_cast(bf16x8, aw), __builtin_bit_cast(bf16x8, bw), o, 0, 0, 0);
                    }
                    const LAS unsigned char* qtp = L + GL_QT + (16 * ti + r16) * 144 + 8 * q;
#pragma unroll
                    for (int s = 0; s < 2; ++s) {
                        const v2u lo = *(const LAS v2u*)(qtp + 64 * s), hi = *(const LAS v2u*)(qtp + 64 * s + 32);
                        const v4u aw = {lo.x, lo.y, hi.x, hi.y};
                        const v4u bw = {cvtpk(S[2 * s][0], S[2 * s][1]), cvtpk(S[2 * s][2], S[2 * s][3]), cvtpk(S[2 * s + 1][0], S[2 * s + 1][1]), cvtpk(S[2 * s + 1][2], S[2 * s + 1][3])};
                        o = __builtin_amdgcn_mfma_f32_16x16x32_bf16(__builtin_bit_cast(bf16x8, aw), __builtin_bit_cast(bf16x8, bw), o, 0, 0, 0);
                    }
                    LAS float* ob = (LAS float*)(L + GL_OB) + (16 * ti + 4 * q) * 132 + 16 * w + r16;
                    ob[0] = o[0]; ob[132] = o[1]; ob[264] = o[2]; ob[396] = o[3];
                }
            }
            {
                bf16x8 vB[2];
#pragma unroll
                for (int s = 0; s < 2; ++s) vB[s] = *(const LAS bf16x8*)(L + GL_VT + (16 * w + r16) * 144 + 64 * s + 16 * q);
#pragma unroll
                for (int td = 0; td < 4; ++td) {
#pragma unroll
                    for (int s = 0; s < 2; ++s) { const bf16x8 ka = *(const LAS bf16x8*)(L + GL_KTT + (16 * td + r16) * 144 + 64 * s + 16 * q); S[td] = __builtin_amdgcn_mfma_f32_16x16x32_bf16(ka, vB[s], S[td], 0, 0, 0); }
                    const f32x4 e4 = *(const LAS f32x4*)(L + GL_EL + (16 * td + 4 * q) * 4);
                    S[td] = S[td] * e4;
                }
            }
            if (OUT) {
                __syncthreads();
                const int row = t >> 3, seg = t & 7;
                const LAS float* ob = (const LAS float*)(L + GL_OB) + row * 132 + 16 * seg;
                f32x4 x[4]; float ss = 0.f;
#pragma unroll
                for (int i = 0; i < 4; ++i) { x[i] = *(const LAS f32x4*)(ob + 4 * i); ss += (x[i][0] * x[i][0] + x[i][1] * x[i][1]) + (x[i][2] * x[i][2] + x[i][3] * x[i][3]); }
                ss += __shfl_xor(ss, 1); ss += __shfl_xor(ss, 2); ss += __shfl_xor(ss, 4);
                const float rn = 1.f / sqrtf(ss * (1.f / 128.f) + EPS);
                const bf16* gop = GO + (tokc + row) * 512 + h * 128 + 16 * seg;
                float gf[16]; unpack8(*(const v4u*)gop, gf); unpack8(*(const v4u*)(gop + 8), gf + 8);
                const f32x4* gp = (const f32x4*)(gng + 16 * seg);
                unsigned ow[8];
#pragma unroll
                for (int i = 0; i < 4; ++i) { const f32x4 gg = gp[i]; const f32x4 y = x[i] * rn * gg;
                    ow[2 * i] = cvtpk(y[0] * gf[4 * i], y[1] * gf[4 * i + 1]); ow[2 * i + 1] = cvtpk(y[2] * gf[4 * i + 2], y[3] * gf[4 * i + 3]); }
                bf16* mp = MIX + (tokc + row) * 1024 + 512 + h * 128 + 16 * seg;
                *(v4u*)mp = (v4u){ow[0], ow[1], ow[2], ow[3]}; *(v4u*)(mp + 8) = (v4u){ow[4], ow[5], ow[6], ow[7]};
            }
        }
        if (!OUT) {
#pragma unroll
            for (int td = 0; td < 4; ++td)
#pragma unroll
                for (int rg = 0; rg < 4; ++rg) SLOC[((size_t)u * 64 + 16 * td + 4 * q + rg) * 128 + 16 * w + r16] = S[td][rg];
            if (erg == 7) ECUM[u * 64 + ed] = __expf(logdec);
        }
        __syncthreads();
    }
}
__global__ void __launch_bounds__(512, 2) fwd_kernel(Params P) {
    extern __shared__ __attribute__((aligned(16))) unsigned char lds[];
    cg::grid_group grid = cg::this_grid();
    Ctx C; C.lds = (LAS unsigned char*)lds; C.tid = threadIdx.x; C.lane = C.tid & 63; C.wave = __builtin_amdgcn_readfirstlane(C.tid >> 6);
    C.gw = blockIdx.x * 8 + C.wave; C.ngw = gridDim.x * 8;
    unsigned char* ws = P.ws;
    const float* ADA = (const float*)(ws + WS_ADA);
    bf16* XN = (bf16*)(ws + WS_XN);
    const int lo = P.ph_lo, hi = P.ph_hi;
#define IN(k) (lo <= (k) && (k) < hi)
#define SEAM(k) do { if (IN(k) && IN((k) + 1)) grid.sync(); } while (0)

    if (IN(0)) p0_prologue(C, P);
    SEAM(0);
    if (IN(1)) xn_pass(C, P.in[0], ADA, 0, 1024, XN);
    SEAM(1);
    if (IN(2)) {
        pg8::Gemm g{XN, (const bf16*)(ws + WS_WIN), M, NPROJ, D}; pg8::StaticOrder S; S.init(M, NPROJ, gridDim.x, (int)blockIdx.x);
        pg8::EpiProj E{(bf16*)(ws + WS_QA), (bf16*)(ws + WS_KVA), (bf16*)(ws + WS_QG), (bf16*)(ws + WS_KG), (bf16*)(ws + WS_VG), (bf16*)(ws + WS_GO), (float*)(ws + WS_LA), P.in[6]};
        pg8::gemm_phase<pg8::EpiProj, pg8::StaticOrder, true, true>(C.lds, g, S, E);
    }
    SEAM(2);
    if (IN(3)) {
#if SWA_MFMA
        swa_mfma_phase(C, P);
#else
        swa_naive_phase(C, P);
#endif
        __syncthreads();
#if GLA_MFMA
        gla_mfma_phase<false>(C, P);
#else
        gla_naive_phase<false>(C, P);
#endif
    }
    SEAM(3);
    if (IN(4)) {
#if GLA_MFMA
        gla_mfma_phase<true>(C, P);
#else
        gla_naive_phase<true>(C, P);
#endif
    }
    SEAM(4);
    if (IN(5)) {
        pg8::Gemm g{(const bf16*)(ws + WS_MIX), (const bf16*)(ws + WS_WOUT), M, D, D}; pg8::StaticOrder S; S.init(M, D, gridDim.x, (int)blockIdx.x);
        pg8::EpiResid E{P.in[0], P.out, ADA + 2048};
        pg8::gemm_phase<pg8::EpiResid, pg8::StaticOrder, true, true>(C.lds, g, S, E);
    }
    SEAM(5);
    if (IN(6)) xn_pass(C, P.out, ADA, 3072, 4096, XN);
    SEAM(6);
    if (IN(7)) {
        pg8::Gemm g{XN, (const bf16*)(ws + WS_W1), M, FF, D}; pg8::StaticOrder S; S.init(M, FF, gridDim.x, (int)blockIdx.x);
        pg8::EpiRelu2 E{(bf16*)(ws + WS_H)};
        pg8::gemm_phase<pg8::EpiRelu2, pg8::StaticOrder, true, true>(C.lds, g, S, E);
    }
    SEAM(7);
    if (IN(8)) {
        pg8::Gemm g{(const bf16*)(ws + WS_H), (const bf16*)(ws + WS_W2), M, D, FF}; pg8::StaticOrder S; S.init(M, D, gridDim.x, (int)blockIdx.x);
        pg8::EpiResid E{P.out, P.out, ADA + 5120};
        pg8::gemm_phase<pg8::EpiResid, pg8::StaticOrder, true, true>(C.lds, g, S, E);
    }
    SEAM(8);
    if (IN(9)) final_norm_pass(C, P.out, P.in[13]);
#undef IN
#undef SEAM
}

extern "C" void kernel_launch(void* const* d_in, const int* in_sizes, int n_in, void* d_out, int out_size, void* d_ws, size_t ws_size, hipStream_t stream) {
    static int grid = 0;
    if (grid == 0) {
        if (n_in != 14 || in_sizes[0] != M * D || out_size != M * D || ws_size < WS_END) { fprintf(stderr, "kernel_launch: unexpected shapes: n_in %d in0 %d out %d ws %zu\n", n_in, n_in > 0 ? in_sizes[0] : -1, out_size, ws_size); grid = -1; return; }
        int dev = 0, cus = 0, per_cu = 0;
        if (hipGetDevice(&dev) != hipSuccess || hipDeviceGetAttribute(&cus, hipDeviceAttributeMultiprocessorCount, dev) != hipSuccess) { fprintf(stderr, "kernel_launch: device query failed\n"); grid = -1; return; }
        if (hipFuncSetAttribute((const void*)fwd_kernel, hipFuncAttributeMaxDynamicSharedMemorySize, LDS_BYTES) != hipSuccess) { fprintf(stderr, "kernel_launch: hipFuncSetAttribute failed\n"); grid = -1; return; }
        if (hipOccupancyMaxActiveBlocksPerMultiprocessor(&per_cu, (const void*)fwd_kernel, 512, LDS_BYTES) != hipSuccess || per_cu < 1) { fprintf(stderr, "kernel_launch: occupancy query says %d blocks per CU\n", per_cu); (void)hipGetLastError(); grid = -1; return; }
        grid = cus;
    }
    if (grid < 0) return;
    if (hipMemsetAsync((char*)d_ws + WS_CTL, 0, CTL_ZERO_BYTES, stream) != hipSuccess) { fprintf(stderr, "kernel_launch: memset failed\n"); return; }
    Params p{};
    for (int i = 0; i < 14; ++i) p.in[i] = (const float*)d_in[i];
    p.out = (float*)d_out; p.ws = (unsigned char*)d_ws;
    constexpr int NL = MK_N_LAUNCHES;
    for (int li = 0; li < NL; ++li) {
        if (NL == 1) { p.ph_lo = 0; p.ph_hi = NPHASE; } else { p.ph_lo = li; p.ph_hi = li + 1; }
        void* args[] = {&p};
        const hipError_t e = hipLaunchCooperativeKernel((const void*)fwd_kernel, dim3(grid), dim3(512), args, LDS_BYTES, stream);
        if (e != hipSuccess) { fprintf(stderr, "kernel_launch: cooperative launch %d failed: %s (grid %d)\n", li, hipGetErrorString(e), grid); break; }
    }
}
```

```cpp
#include <hip/hip_runtime.h>
#include <cstdio>
#include <cstdint>

#ifndef SWA_MFMA
#define SWA_MFMA 1
#endif
#ifndef GLA_MFMA
#define GLA_MFMA 1
#endif
#ifndef MK_N_LAUNCHES
#define MK_N_LAUNCHES 1
#endif

constexpr int BATCH = 8, T = 8192, D = 1024, M = BATCH * T, FF = 4096;
constexpr int NPROJ = 2560;
constexpr int DIN = 2320;
constexpr float EPS = 1e-6f;
constexpr float LOG2E = 1.4426950408889634f;
constexpr int NPHASE = 10;

constexpr size_t MiB = 1u << 20;
constexpr size_t WS_CTL = 0, CTL_ZERO_BYTES = 1 * MiB;
constexpr size_t WS_ADA = 512 * 1024;
constexpr size_t WS_WIN = 2 * MiB, WS_WOUT = 8 * MiB, WS_W1 = 10 * MiB, WS_W2 = 18 * MiB;
constexpr size_t WS_SLOC = 32 * MiB, WS_ECUM = 48 * MiB;
constexpr size_t WS_XN = 64 * MiB;
constexpr size_t WS_QA = 192 * MiB, WS_KVA = 256 * MiB, WS_QG = 288 * MiB, WS_KG = 320 * MiB, WS_VG = 352 * MiB, WS_GO = 416 * MiB, WS_LA = 480 * MiB, WS_MIX = 544 * MiB;
constexpr size_t WS_H = 192 * MiB;
constexpr size_t WS_END = 704 * MiB;

constexpr int LDSCTL_OFF = 131072, MISC_OFF = LDSCTL_OFF + 320;
constexpr int CW_BAR = 4096;
constexpr int LDS_BYTES = 147456;

__constant__ unsigned char T5_BUCKET[128] = {0, 1, 2, 3, 4, 5, 6, 7, 8, 9, 10, 11, 12, 13, 14, 15, 16, 16, 16, 17, 17, 18, 18, 18, 19, 19, 19, 20, 20, 20, 20, 21, 21, 21, 21, 22, 22, 22, 22, 22, 23, 23, 23, 23, 23, 23, 24, 24, 24, 24, 24, 24, 25, 25, 25, 25, 25, 25, 25, 26, 26, 26, 26, 26, 26, 26, 26, 27, 27, 27, 27, 27, 27, 27, 27, 27, 27, 28, 28, 28, 28, 28, 28, 28, 28, 28, 28, 29, 29, 29, 29, 29, 29, 29, 29, 29, 29, 29, 29, 30, 30, 30, 30, 30, 30, 30, 30, 30, 30, 30, 30, 30, 30, 31, 31, 31, 31, 31, 31, 31, 31, 31, 31, 31, 31, 31, 31, 31};

namespace pg8 {
#define PG8_LAS __attribute__((address_space(3)))
typedef unsigned short bf16_t;
typedef short bf16x8 __attribute__((ext_vector_type(8)));
typedef float f32x4 __attribute__((ext_vector_type(4)));
typedef unsigned u32x4 __attribute__((ext_vector_type(4)));
constexpr int BM = 256, BK = 64, HALF = 128, HTB = HALF * BK * 2  , STAGE_BYTES = 8 * HTB, NXCD = 8, WGM = 8;

__host__ __device__ __forceinline__ int lds_byte(int r, int c) { const int st = (r >> 4) * 2 + (c >> 5), rr = r & 15, cc = c & 31, ob = rr * 64 + cc * 2; return st * 1024 + (ob ^ (((ob >> 9) & 1) << 5)); }
__host__ __device__ __forceinline__ void stage_rc(int b, int& R, int& C) { const int st = b / 1024, sb = b % 1024, swz = sb ^ (((sb >> 9) & 1) << 5); R = (st >> 1) * 16 + swz / 64; C = (st & 1) * 32 + (swz % 64) / 2; }
__host__ __device__ __forceinline__ int perm32(int rho) { const int n = rho >> 4, i = rho & 15; return 8 * (i >> 2) + 4 * n + (i & 3); }

struct Unit { int pm, pn; };
struct Gemm { const bf16_t* A; const bf16_t* Bt; int M, N, K; };

struct StaticOrder {
    int nM, nN, nwg, G, c;
    __host__ __device__ void init(int M, int N, int G_, int c_) { nM = M / BM; nN = N / BM; nwg = nM * nN; G = G_; c = c_; }
    __host__ __device__ bool next(int i, Unit& u) const {
        const long L = (long)i * G + c; if (L >= nwg) return false;
        int wgid = (int)L; { const int q = nwg / NXCD, r = nwg % NXCD, xcd = wgid % NXCD, off = wgid / NXCD; wgid = (xcd < r ? xcd * (q + 1) : r * (q + 1) + (xcd - r) * q) + off; }
        const int nig = WGM * nN, gid = wgid / nig, fm = gid * WGM, gsz = (nM - fm) < WGM ? (nM - fm) : WGM;
        u.pm = fm + ((wgid % nig) % gsz); u.pn = (wgid % nig) / gsz; return true;
    }
    __device__ __forceinline__ void a_ready(const Unit&) const {}
    __device__ __forceinline__ void done(const Unit&) const {}
};

__device__ __forceinline__ unsigned cvt_pk_bf16(float lo, float hi) { unsigned r; asm volatile("v_cvt_pk_bf16_f32 %0, %1, %2" : "=v"(r) : "v"(lo), "v"(hi)); return r; }
typedef float f32x2 __attribute__((ext_vector_type(2)));
__device__ __forceinline__ float silu_f(float v) { return v / (1.f + __expf(-v)); }
__device__ __forceinline__ float logsig_f(float v) { return fminf(v, 0.f) - __logf(1.f + __expf(-fabsf(v))); }

struct EpiProj {
    static constexpr bool PERM = true, AFTER_DRAIN = false;
    bf16_t *QA, *KVA, *QG, *KG, *VG, *GO; float* LA; const float* b_gate;
    __device__ __forceinline__ void operator()(const f32x4 (&acc)[2][2][4][2], const Unit& u, int wr, int wc, int fr, int fq) const {
        const int row0 = u.pm * BM + wr * 64 + fr, ct = wc * 32 + 8 * fq, pn = u.pn;
        if (pn == 9) {
            f32x4 bg[2][2];
#pragma unroll
            for (int bj = 0; bj < 2; ++bj)
#pragma unroll
                for (int n = 0; n < 2; ++n) bg[bj][n] = *(const f32x4*)(b_gate + ct + bj * HALF + 4 * n);
#pragma unroll
            for (int ai = 0; ai < 2; ++ai)
#pragma unroll
                for (int m = 0; m < 4; ++m) { float* rowp = LA + (size_t)(row0 + ai * HALF + m * 16) * 256 + ct;
#pragma unroll
                    for (int bj = 0; bj < 2; ++bj)
#pragma unroll
                        for (int n = 0; n < 2; ++n) { const f32x4 v = acc[ai][bj][m][n] + bg[bj][n]; f32x4 o;
                            o[0] = logsig_f(v[0]) * 0.0625f; o[1] = logsig_f(v[1]) * 0.0625f; o[2] = logsig_f(v[2]) * 0.0625f; o[3] = logsig_f(v[3]) * 0.0625f;
                            *(f32x4*)(rowp + bj * HALF + 4 * n) = o; } }
            return;
        }
        bf16_t* base; int ldc, coff = 0; float sc = 1.f;
        if (pn < 2) { base = QA; ldc = 512; coff = pn * 256; sc = 0.125f * 1.4426950408889634f; }
        else if (pn == 2) { base = KVA; ldc = 256; }
        else if (pn == 3) { base = QG; ldc = 256; sc = 0.125f; }
        else if (pn == 4) { base = KG; ldc = 256; }
        else if (pn < 7) { base = VG; ldc = 512; coff = (pn - 5) * 256; }
        else { base = GO; ldc = 512; coff = (pn - 7) * 256; }
        const bool act = pn >= 7;
#pragma unroll
        for (int ai = 0; ai < 2; ++ai)
#pragma unroll
            for (int m = 0; m < 4; ++m) { bf16_t* rowp = base + (size_t)(row0 + ai * HALF + m * 16) * ldc + coff + ct;
#pragma unroll
                for (int bj = 0; bj < 2; ++bj) { f32x4 v0 = acc[ai][bj][m][0], v1 = acc[ai][bj][m][1];
                    if (act) { v0[0] = silu_f(v0[0]); v0[1] = silu_f(v0[1]); v0[2] = silu_f(v0[2]); v0[3] = silu_f(v0[3]); v1[0] = silu_f(v1[0]); v1[1] = silu_f(v1[1]); v1[2] = silu_f(v1[2]); v1[3] = silu_f(v1[3]); }
                    else { v0 = v0 * sc; v1 = v1 * sc; }
                    u32x4 w; w.x = cvt_pk_bf16(v0[0], v0[1]); w.y = cvt_pk_bf16(v0[2], v0[3]); w.z = cvt_pk_bf16(v1[0], v1[1]); w.w = cvt_pk_bf16(v1[2], v1[3]);
                    *(u32x4*)(rowp + bj * HALF) = w; } }
    }
};
struct EpiResid {
    static constexpr bool PERM = false, AFTER_DRAIN = false;
    const float* base; float* out; const float* gate;
    __device__ __forceinline__ void operator()(const f32x4 (&acc)[2][2][4][2], const Unit& u, int wr, int wc, int fr, int fq) const {
        const int row0 = u.pm * BM + wr * 64 + fr, col0 = u.pn * BM + wc * 32 + 4 * fq, b = u.pm >> 5;
        f32x4 gv[2][2];
#pragma unroll
        for (int bj = 0; bj < 2; ++bj)
#pragma unroll
            for (int n = 0; n < 2; ++n) gv[bj][n] = *(const f32x4*)(gate + (size_t)b * 6144 + col0 + bj * HALF + n * 16);
#pragma unroll
        for (int ai = 0; ai < 2; ++ai)
#pragma unroll
            for (int m = 0; m < 4; ++m) { const size_t off = (size_t)(row0 + ai * HALF + m * 16) * 1024 + col0;
#pragma unroll
                for (int bj = 0; bj < 2; ++bj)
#pragma unroll
                    for (int n = 0; n < 2; ++n) { const f32x4 bs = *(const f32x4*)(base + off + bj * HALF + n * 16); *(f32x4*)(out + off + bj * HALF + n * 16) = bs + gv[bj][n] * acc[ai][bj][m][n]; }
                if (m & 1) asm volatile("" ::: "memory"); }
    }
};
struct EpiRelu2 {
    static constexpr bool PERM = true, AFTER_DRAIN = false;
    bf16_t* H;
    __device__ __forceinline__ void operator()(const f32x4 (&acc)[2][2][4][2], const Unit& u, int wr, int wc, int fr, int fq) const {
        const int row0 = u.pm * BM + wr * 64 + fr, col0 = u.pn * BM + wc * 32 + 8 * fq;
#pragma unroll
        for (int ai = 0; ai < 2; ++ai)
#pragma unroll
            for (int m = 0; m < 4; ++m) { bf16_t* rowp = H + (size_t)(row0 + ai * HALF + m * 16) * 4096 + col0;
#pragma unroll
                for (int bj = 0; bj < 2; ++bj) { f32x4 v0 = acc[ai][bj][m][0], v1 = acc[ai][bj][m][1];
                    v0 = __builtin_elementwise_max(v0, (f32x4){0.f, 0.f, 0.f, 0.f}); v1 = __builtin_elementwise_max(v1, (f32x4){0.f, 0.f, 0.f, 0.f}); v0 = v0 * v0; v1 = v1 * v1;
                    u32x4 w; w.x = cvt_pk_bf16(v0[0], v0[1]); w.y = cvt_pk_bf16(v0[2], v0[3]); w.z = cvt_pk_bf16(v1[0], v1[1]); w.w = cvt_pk_bf16(v1[2], v1[3]);
                    *(u32x4*)(rowp + bj * HALF) = w; } }
    }
};

template <class Epi, class Sched, bool ALIGN_EPI = false, bool SP2 = false>
__device__ __forceinline__ void gemm_phase(PG8_LAS unsigned char* lds, const Gemm g, const Sched& S, const Epi& E) {
    const int tid = threadIdx.x, wid = __builtin_amdgcn_readfirstlane(tid >> 6), lane = tid & 63, wr = wid >> 2, wc = wid & 3, fr = lane & 15, fq = lane >> 4;
    const int K = g.K, nt = K / BK;
    unsigned voffA[2], voffB[2];
#pragma unroll
    for (int i = 0; i < 2; ++i) { int R, C; stage_rc(tid * 16 + i * 8192, R, C); const int Rb = Epi::PERM ? ((R & ~31) + perm32(R & 31)) : R;
        voffA[i] = (unsigned)(R * K + C) * 2u; voffB[i] = (unsigned)(Rb * K + C) * 2u; }
    const size_t kstep = (size_t)(BK * 2);
    const size_t hstep = (size_t)HALF * K * 2;
    const size_t tstep = 2 * hstep;
    const unsigned ldsw = (unsigned)wid * 1024u;
    const int aoff = lds_byte(wr * 64 + fr, fq * 8), boff = lds_byte(wc * 32 + fr, fq * 8);
#define PG8_SA(b, h) (((b) * 2 + (h)) * HTB)
#define PG8_SB(b, h) ((4 + (b) * 2 + (h)) * HTB)
#define PG8_STAGE(bufoff, gbase, voff) do { _Pragma("unroll") for (int _i = 0; _i < 2; ++_i) \
        __builtin_amdgcn_global_load_lds((const unsigned*)((const char*)(gbase) + (voff)[_i]), (PG8_LAS unsigned*)(lds + (bufoff) + ldsw + _i * 8192), 16, 0, 0); } while (0)
#define PG8_LDA(dst, b, h) do { _Pragma("unroll") for (int m = 0; m < 4; ++m) _Pragma("unroll") for (int k = 0; k < 2; ++k) dst[m][k] = *(const PG8_LAS bf16x8*)(lds + PG8_SA(b, h) + aoff + m * 2048 + k * 1024); } while (0)
#define PG8_LDB(dst, b, h) do { _Pragma("unroll") for (int n = 0; n < 2; ++n) _Pragma("unroll") for (int k = 0; k < 2; ++k) dst[n][k] = *(const PG8_LAS bf16x8*)(lds + PG8_SB(b, h) + boff + n * 2048 + k * 1024); } while (0)
#define PG8_MMA(ai, bj, At, Bt) do { __builtin_amdgcn_s_setprio(1); _Pragma("unroll") for (int m = 0; m < 4; ++m) _Pragma("unroll") for (int n = 0; n < 2; ++n) _Pragma("unroll") for (int k = 0; k < 2; ++k) \
        acc[ai][bj][m][n] = __builtin_amdgcn_mfma_f32_16x16x32_bf16(Bt[n][k], At[m][k], acc[ai][bj][m][n], 0, 0, 0); __builtin_amdgcn_s_setprio(0); } while (0)
#define PG8_WAIT_V(n) asm volatile("s_waitcnt vmcnt(" #n ")" ::: "memory")
#define PG8_WAIT_L(n) asm volatile("s_waitcnt lgkmcnt(" #n ")" ::: "memory")
#define PG8_BAR __builtin_amdgcn_s_barrier()
#define PG8_SCHED __builtin_amdgcn_sched_barrier(0)
    Unit cur, nxt; int ui = 0;
    if (!S.next(0, cur)) return;
    f32x4 acc[2][2][4][2];
#pragma unroll
    for (int a = 0; a < 2; ++a)
#pragma unroll
        for (int b = 0; b < 2; ++b)
#pragma unroll
            for (int m = 0; m < 4; ++m)
#pragma unroll
                for (int n = 0; n < 2; ++n) acc[a][b][m][n] = (f32x4){0.f, 0.f, 0.f, 0.f};
    bf16x8 At[4][2], B0[2][2], B1[2][2];
    const char* cA = (const char*)g.A + (size_t)cur.pm * tstep; const char* cB = (const char*)g.Bt + (size_t)cur.pn * tstep;
    S.a_ready(cur);
    if constexpr (SP2) {
        PG8_STAGE(PG8_SB(0, 0), cB, voffB); PG8_STAGE(PG8_SB(0, 1), cB + hstep, voffB); PG8_STAGE(PG8_SA(0, 0), cA, voffA); PG8_STAGE(PG8_SA(0, 1), cA + hstep, voffA);
        if (wr == 1) PG8_BAR;
        PG8_WAIT_V(2); PG8_BAR;
        PG8_STAGE(PG8_SB(1, 0), cB + kstep, voffB); PG8_STAGE(PG8_SA(1, 0), cA + kstep, voffA); PG8_STAGE(PG8_SB(1, 1), cB + hstep + kstep, voffB);
        PG8_WAIT_V(6); PG8_BAR;
    } else {
        PG8_STAGE(PG8_SB(0, 0), cB, voffB); PG8_STAGE(PG8_SA(0, 0), cA, voffA); PG8_STAGE(PG8_SB(0, 1), cB + hstep, voffB); PG8_STAGE(PG8_SA(0, 1), cA + hstep, voffA);
        if (wr == 1) PG8_BAR;
        PG8_WAIT_V(4); PG8_BAR;
        PG8_STAGE(PG8_SB(1, 0), cB + kstep, voffB); PG8_STAGE(PG8_SA(1, 0), cA + kstep, voffA); PG8_STAGE(PG8_SB(1, 1), cB + hstep + kstep, voffB);
        PG8_WAIT_V(6); PG8_BAR;
    }
    for (;;) {
        const bool has_next = S.next(ui + 1, nxt);
        const char* nA = has_next ? (const char*)g.A + (size_t)nxt.pm * tstep : cA; const char* nB = has_next ? (const char*)g.Bt + (size_t)nxt.pn * tstep : cB;
        for (int t = 0; t < nt; t += 2) {
            const bool last = (t == nt - 2);
            const char* a1 = cA + (size_t)(t + 1) * kstep;
            const char* a2 = last ? nA : cA + (size_t)(t + 2) * kstep; const char* b2 = last ? nB : cB + (size_t)(t + 2) * kstep;
            const char* a3 = a2 + kstep; const char* b3 = b2 + kstep;
            if (last && has_next) S.a_ready(nxt);
            if constexpr (SP2) {
            PG8_LDB(B0, 0, 0); PG8_LDB(B1, 0, 1); PG8_SCHED; PG8_LDA(At, 0, 0); PG8_STAGE(PG8_SA(1, 1), a1 + hstep, voffA);
            PG8_WAIT_V(8); PG8_WAIT_L(0); PG8_BAR; PG8_MMA(0, 0, At, B0); PG8_MMA(0, 1, At, B1); PG8_BAR; PG8_SCHED;
            PG8_LDA(At, 0, 1); PG8_STAGE(PG8_SB(0, 0), b2, voffB); PG8_STAGE(PG8_SB(0, 1), b2 + hstep, voffB); PG8_STAGE(PG8_SA(0, 0), a2, voffA);
            PG8_WAIT_V(8); PG8_WAIT_L(0); PG8_BAR; PG8_MMA(1, 0, At, B0); PG8_MMA(1, 1, At, B1); PG8_BAR; PG8_SCHED;
            PG8_LDB(B0, 1, 0); PG8_LDB(B1, 1, 1); PG8_SCHED; PG8_LDA(At, 1, 0); PG8_STAGE(PG8_SA(0, 1), a2 + hstep, voffA);
            PG8_WAIT_V(8); PG8_WAIT_L(0); PG8_BAR; PG8_MMA(0, 0, At, B0); PG8_MMA(0, 1, At, B1); PG8_BAR; PG8_SCHED;
            PG8_LDA(At, 1, 1); PG8_STAGE(PG8_SB(1, 0), b3, voffB); PG8_STAGE(PG8_SB(1, 1), b3 + hstep, voffB); PG8_STAGE(PG8_SA(1, 0), a3, voffA);
            PG8_WAIT_V(8); PG8_WAIT_L(0); PG8_BAR; PG8_MMA(1, 0, At, B0); PG8_MMA(1, 1, At, B1); PG8_BAR; PG8_SCHED;
            } else {
            PG8_LDB(B0, 0, 0); PG8_SCHED; PG8_LDA(At, 0, 0); PG8_STAGE(PG8_SA(1, 1), a1 + hstep, voffA);
            PG8_WAIT_L(8); PG8_BAR; PG8_WAIT_L(0); PG8_MMA(0, 0, At, B0); PG8_BAR; PG8_SCHED;
            PG8_LDB(B1, 0, 1); PG8_STAGE(PG8_SB(0, 0), b2, voffB);
            PG8_BAR; PG8_WAIT_L(0); PG8_MMA(0, 1, At, B1); PG8_BAR;
            PG8_LDA(At, 0, 1); PG8_STAGE(PG8_SA(0, 0), a2, voffA);
            PG8_BAR; PG8_WAIT_L(0); PG8_MMA(1, 0, At, B0); PG8_BAR; PG8_SCHED;
            PG8_STAGE(PG8_SB(0, 1), b2 + hstep, voffB);
            PG8_WAIT_V(6); PG8_BAR; PG8_MMA(1, 1, At, B1); PG8_BAR;
            PG8_LDB(B0, 1, 0); PG8_SCHED; PG8_LDA(At, 1, 0); PG8_STAGE(PG8_SA(0, 1), a2 + hstep, voffA);
            PG8_WAIT_L(8); PG8_BAR; PG8_WAIT_L(0); PG8_MMA(0, 0, At, B0); PG8_BAR; PG8_SCHED;
            PG8_LDB(B1, 1, 1); PG8_STAGE(PG8_SB(1, 0), b3, voffB);
            PG8_BAR; PG8_WAIT_L(0); PG8_MMA(0, 1, At, B1); PG8_BAR;
            PG8_LDA(At, 1, 1); PG8_STAGE(PG8_SA(1, 0), a3, voffA);
            PG8_BAR; PG8_WAIT_L(0); PG8_MMA(1, 0, At, B0); PG8_BAR; PG8_SCHED;
            PG8_STAGE(PG8_SB(1, 1), b3 + hstep, voffB);
            PG8_WAIT_V(6); PG8_BAR; PG8_MMA(1, 1, At, B1); PG8_BAR;
            }
        }
        if constexpr (ALIGN_EPI) { if (wr == 0) PG8_BAR; }
        if constexpr (!Epi::AFTER_DRAIN) { E(acc, cur, wr, wc, fr, fq); S.done(cur); }
        if (!has_next) break;
#pragma unroll
        for (int a = 0; a < 2; ++a)
#pragma unroll
            for (int b = 0; b < 2; ++b)
#pragma unroll
                for (int m = 0; m < 4; ++m)
#pragma unroll
                    for (int n = 0; n < 2; ++n) acc[a][b][m][n] = (f32x4){0.f, 0.f, 0.f, 0.f};
        cur = nxt; cA = nA; cB = nB; ++ui;
        if constexpr (ALIGN_EPI) { if (wr == 1) PG8_BAR; }
    }
    PG8_WAIT_V(0);
    if constexpr (!ALIGN_EPI) { if (wr == 0) PG8_BAR; }
    PG8_BAR;
    if constexpr (Epi::AFTER_DRAIN) { E.fused(acc, cur, wr, wc, fr, fq, lds, wid, lane); S.done(cur); }
#undef PG8_SA
#undef PG8_SB
#undef PG8_STAGE
#undef PG8_LDA
#undef PG8_LDB
#undef PG8_MMA
#undef PG8_WAIT_V
#undef PG8_WAIT_L
#undef PG8_BAR
#undef PG8_SCHED
}
}
#define GAS __attribute__((address_space(1)))
#define LAS __attribute__((address_space(3)))
typedef unsigned short bf16;
typedef unsigned v4u __attribute__((ext_vector_type(4)));
typedef float f32x4 __attribute__((ext_vector_type(4)));
typedef short bf16x8 __attribute__((ext_vector_type(8)));
typedef GAS unsigned gu32;
typedef GAS unsigned long long gu64;
#define RLX_AGENT __ATOMIC_RELAXED, __HIP_MEMORY_SCOPE_AGENT
#define LDS_WAIT() asm volatile("s_waitcnt lgkmcnt(0)" ::: "memory")
#define VM_WAIT() asm volatile("s_waitcnt vmcnt(0)" ::: "memory")
__device__ __forceinline__ unsigned long long rt() { return __builtin_amdgcn_s_memrealtime(); }
__device__ __forceinline__ unsigned f2bf(float f) { unsigned u = __builtin_bit_cast(unsigned, f); return (u + 0x7fffu + ((u >> 16) & 1u)) >> 16; }
__device__ __forceinline__ unsigned pk2(float lo, float hi) { return f2bf(lo) | (f2bf(hi) << 16); }

#define XB_TMO      128
#define XB_XCNT(j)  (256  + 64 * (j))
#define XB_XSUB(j)  (1280 + 64 * (j))
#define XB_XGEN(j)  (2304 + 64 * (j))
#define XB_TOP      3328
#define XB_TOPGEN   3392
#define XCD_BAR_WORDS 3456
#define XB_SPIN_CAP (1u << 18)

__device__ __forceinline__ unsigned xb_ld(unsigned* p)              { return __hip_atomic_load(p, __ATOMIC_RELAXED, __HIP_MEMORY_SCOPE_AGENT); }
__device__ __forceinline__ unsigned xb_add(unsigned* p, unsigned v) { return __hip_atomic_fetch_add(p, v, __ATOMIC_RELAXED, __HIP_MEMORY_SCOPE_AGENT); }
__device__ __forceinline__ unsigned xb_xcc_id() { return (unsigned)__builtin_amdgcn_s_getreg((3 << 11) | 20) & 0xFu; }
#define XB_SPIN(cond, bar) do { unsigned _sp = 0; while (cond) { __builtin_amdgcn_s_sleep(1); \
    if ((++_sp & 255u) == 0u) { if (xb_ld(&(bar)[XB_TMO])) break; if (_sp > XB_SPIN_CAP) { atomicAdd(&(bar)[XB_TMO], 1u); break; } } } } while (0)

struct XcdBarrier {
    unsigned* bar; unsigned x;
    volatile LAS unsigned* st;
};

__device__ __forceinline__ XcdBarrier xcd_barrier_post(unsigned* bar, volatile LAS unsigned* st) {
    XcdBarrier b; b.bar = bar; b.x = xb_xcc_id(); b.st = st;
    if (threadIdx.x == 0) (void)xb_add(&bar[XB_XCNT(b.x)], 1u);
    return b;
}
__device__ __forceinline__ void xcd_barrier_complete(unsigned* bar, unsigned x, unsigned& nloc, unsigned& nx) {
    const unsigned G = gridDim.x * gridDim.y * gridDim.z;
    unsigned sum, cnt, mine, sp = 0u;
    for (;;) {
        sum = 0u; cnt = 0u; mine = 0u;
#pragma unroll
        for (unsigned j = 0; j < 16; ++j) { const unsigned c = xb_ld(&bar[XB_XCNT(j)]); sum += c; cnt += (c > 0u) ? 1u : 0u; mine = (j == x) ? c : mine; }
        if (sum == G) break;
        __builtin_amdgcn_s_sleep(1);
        if ((++sp & 255u) == 0u) { if (xb_ld(&bar[XB_TMO])) break; if (sp > XB_SPIN_CAP) { atomicAdd(&bar[XB_TMO], 1u); break; } }
    }
    nloc = mine > 0u ? mine : 1u; nx = cnt > 0u ? cnt : 1u;
}

__device__ __forceinline__ void xcd_barrier(const XcdBarrier& b) {
    asm volatile("s_waitcnt vmcnt(0)" ::: "memory");
    __syncthreads();
    if (threadIdx.x == 0) {
        unsigned* bar = b.bar;
        __builtin_amdgcn_s_waitcnt(0);
        unsigned nloc = b.st[0], nx = b.st[1];
        if (nloc == 0u) { xcd_barrier_complete(bar, b.x, nloc, nx); b.st[0] = nloc; b.st[1] = nx; }
        const unsigned old = xb_add(&bar[XB_XSUB(b.x)], 1u);
        const unsigned gen = old / nloc;
        if (old + 1u == (gen + 1u) * nloc) {
            __builtin_amdgcn_fence(__ATOMIC_RELEASE, "agent");
            asm volatile("s_waitcnt vmcnt(0)" ::: "memory");
            const unsigned og = xb_add(&bar[XB_TOP], 1u);
            const unsigned tg = og / nx;
            if (og + 1u == (tg + 1u) * nx) xb_add(&bar[XB_TOPGEN], 1u);
            else XB_SPIN(xb_ld(&bar[XB_TOPGEN]) == tg, bar);
            __builtin_amdgcn_fence(__ATOMIC_ACQUIRE, "agent");
            xb_add(&bar[XB_XGEN(b.x)], 1u);
            asm volatile("s_waitcnt vmcnt(0)" ::: "memory");
        } else {
            XB_SPIN(xb_ld(&bar[XB_XGEN(b.x)]) == gen, bar);
            __builtin_amdgcn_fence(__ATOMIC_ACQUIRE, "agent");
            asm volatile("s_waitcnt vmcnt(0)" ::: "memory");
        }
    }
    __syncthreads();
}

__device__ __forceinline__ float bf2f(unsigned short h) { return __uint_as_float((unsigned)h << 16); }
__device__ __forceinline__ float wave_sum(float v) {
#pragma unroll
    for (int o = 1; o < 64; o <<= 1) v += __shfl_xor(v, o);
    return v;
}
__device__ __forceinline__ void unpack8(const v4u w, float* f) {
    f[0] = __uint_as_float(w.x << 16); f[1] = __uint_as_float(w.x & 0xffff0000u); f[2] = __uint_as_float(w.y << 16); f[3] = __uint_as_float(w.y & 0xffff0000u);
    f[4] = __uint_as_float(w.z << 16); f[5] = __uint_as_float(w.z & 0xffff0000u); f[6] = __uint_as_float(w.w << 16); f[7] = __uint_as_float(w.w & 0xffff0000u);
}

struct Params { const float* in[14]; float* out; unsigned char* ws; int ph_lo, ph_hi; };
struct Ctx { LAS unsigned char* lds; int tid, lane, wave, gw, ngw; };

__device__ __forceinline__ void transpose_item(const float* W, int ldw, int nblk, int K, bf16* WT, LAS float* scr, int item, int lane) {
    const int kb = item / nblk, nb = item % nblk, k0 = 64 * kb, n0 = 32 * nb;
#pragma unroll 8
    for (int i = 0; i < 32; ++i) { const int kk = 2 * i + (lane >> 5); scr[kk * 33 + (lane & 31)] = W[(size_t)(k0 + kk) * ldw + n0 + (lane & 31)]; }
    LDS_WAIT(); asm volatile("" ::: "memory");
    const int c = lane & 7;
#pragma unroll
    for (int j = 0; j < 4; ++j) { const int n = (lane >> 3) + 8 * j; const LAS float* s = scr + (8 * c) * 33 + n;
        v4u o; o.x = pk2(s[0 * 33], s[1 * 33]); o.y = pk2(s[2 * 33], s[3 * 33]); o.z = pk2(s[4 * 33], s[5 * 33]); o.w = pk2(s[6 * 33], s[7 * 33]);
        *(GAS v4u*)(WT + (size_t)(n0 + n) * K + k0 + 8 * c) = o; }
    LDS_WAIT(); asm volatile("" ::: "memory");
}
__device__ __forceinline__ void p0_prologue(const Ctx& C, const Params& P) {
    LAS float* scr = (LAS float*)(C.lds + C.wave * 16384);
    unsigned char* ws = P.ws;
    const float* cin = P.in[1]; const float* w_ada = P.in[2]; const float* b_ada = P.in[3]; const float* w_in = P.in[4]; const float* wgu = P.in[5];
    float* ADA = (float*)(ws + WS_ADA);
    bf16* WIN = (bf16*)(ws + WS_WIN);
    constexpr int I_ADA = 96 * 8, I_IN = 16 * 72, I_OUT = 16 * 32, I_1 = 16 * 128, I_2 = 64 * 32, I_Z = 256 * 16;
    constexpr int NITEMS = I_ADA + I_IN + I_OUT + I_1 + I_2 + I_Z;
    for (int it = C.gw; it < NITEMS; it += C.ngw) {
        int r = it; const int lane = C.lane;
        if (r < I_ADA) {
            const int cgi = r >> 3, ks = r & 7, n = cgi * 64 + lane, k0 = ks * 128;
#pragma unroll
            for (int i = 0; i < 16; ++i) { const int idx = i * 64 + lane, b = idx >> 7, k = idx & 127; const float cv = cin[b * 1024 + k0 + k]; scr[k * 8 + b] = cv / (1.f + __expf(-cv)); }
            LDS_WAIT(); asm volatile("" ::: "memory");
            float a[8];
#pragma unroll
            for (int b = 0; b < 8; ++b) a[b] = 0.f;
#pragma unroll 4
            for (int k = 0; k < 128; ++k) { const float w = w_ada[(size_t)(k0 + k) * 6144 + n]; const f32x4 c0 = *(const LAS f32x4*)(scr + k * 8), c1 = *(const LAS f32x4*)(scr + k * 8 + 4);
                a[0] += c0[0] * w; a[1] += c0[1] * w; a[2] += c0[2] * w; a[3] += c0[3] * w; a[4] += c1[0] * w; a[5] += c1[1] * w; a[6] += c1[2] * w; a[7] += c1[3] * w; }
            const float bb = (ks == 0) ? b_ada[n] : 0.f;
#pragma unroll
            for (int b = 0; b < 8; ++b) atomicAdd(ADA + b * 6144 + n, a[b] + bb);
            LDS_WAIT(); asm volatile("" ::: "memory");
            continue; }
        r -= I_ADA;
        if (r < I_IN) { transpose_item(w_in, DIN, 72, D, WIN, scr, r, lane); continue; } r -= I_IN;
        if (r < I_OUT) { transpose_item(P.in[10], D, 32, D, (bf16*)(ws + WS_WOUT), scr, r, lane); continue; } r -= I_OUT;
        if (r < I_1) { transpose_item(P.in[11], FF, 128, D, (bf16*)(ws + WS_W1), scr, r, lane); continue; } r -= I_1;
        if (r < I_2) { transpose_item(P.in[12], D, 32, FF, (bf16*)(ws + WS_W2), scr, r, lane); continue; } r -= I_2;
        {
            const int n = r >> 4, k = (r & 15) * 64 + lane; const float* wr = w_in + (size_t)k * DIN + 2304; float acc = 0.f;
#pragma unroll
            for (int q = 0; q < 4; ++q) { const f32x4 wv = *(const f32x4*)(wr + 4 * q);
                acc += wv[0] * wgu[(4 * q + 0) * 256 + n] + wv[1] * wgu[(4 * q + 1) * 256 + n] + wv[2] * wgu[(4 * q + 2) * 256 + n] + wv[3] * wgu[(4 * q + 3) * 256 + n]; }
            WIN[(size_t)(2304 + n) * D + k] = (bf16)f2bf(acc);
        }
    }
}

__device__ __forceinline__ void xn_pass(const Ctx& C, const float* src, const float* ADA, int shift_off, int scale_off, bf16* XN) {
    for (int m = C.gw; m < M; m += C.ngw) {
        const GAS f32x4* xr = (const GAS f32x4*)(src + (size_t)m * D) + C.lane;
        f32x4 v[4]; float s = 0.f;
#pragma unroll
        for (int j = 0; j < 4; ++j) { v[j] = xr[64 * j]; s += (v[j].x * v[j].x + v[j].y * v[j].y) + (v[j].z * v[j].z + v[j].w * v[j].w); }
        const float rstd = 1.f / sqrtf(wave_sum(s) * (1.f / D) + EPS);
        const int b = m >> 13;
        const f32x4* sc = (const f32x4*)(ADA + b * 6144 + scale_off) + C.lane; const f32x4* sh = (const f32x4*)(ADA + b * 6144 + shift_off) + C.lane;
        GAS unsigned long long* o8 = (GAS unsigned long long*)(XN + (size_t)m * D) + C.lane;
#pragma unroll
        for (int j = 0; j < 4; ++j) { const f32x4 a = sc[64 * j], h = sh[64 * j]; const f32x4 o = v[j] * rstd * (a + 1.f) + h;
            o8[64 * j] = (unsigned long long)pk2(o.x, o.y) | ((unsigned long long)pk2(o.z, o.w) << 32); }
    }
}
__device__ __forceinline__ void final_norm_pass(const Ctx& C, float* xo, const float* g) {
    for (int m = C.gw; m < M; m += C.ngw) {
        GAS f32x4* xr = (GAS f32x4*)(xo + (size_t)m * D) + C.lane;
        f32x4 v[4]; float s = 0.f;
#pragma unroll
        for (int j = 0; j < 4; ++j) { v[j] = xr[64 * j]; s += (v[j].x * v[j].x + v[j].y * v[j].y) + (v[j].z * v[j].z + v[j].w * v[j].w); }
        const float rstd = 1.f / sqrtf(wave_sum(s) * (1.f / D) + EPS);
        const f32x4* gg = (const f32x4*)g + C.lane;
#pragma unroll
        for (int j = 0; j < 4; ++j) xr[64 * j] = v[j] * rstd * gg[64 * j];
    }
}

__device__ __forceinline__ void swa_naive_phase(const Ctx& C, const Params& P) {
    LAS float* KsL = (LAS float*)C.lds; LAS float* VsL = KsL + 256 * 68; LAS float* BtL = VsL + 256 * 68;
    const bf16* QA = (const bf16*)(P.ws + WS_QA); const bf16* KVA = (const bf16*)(P.ws + WS_KVA); bf16* MIX = (bf16*)(P.ws + WS_MIX);
    const float* sinks = P.in[8]; const float* rel_bias = P.in[9];
    const int t = C.tid;
    for (int unit = blockIdx.x; unit < 1024; unit += gridDim.x) {
        const int b = unit >> 7, kvh = (unit >> 6) & 1, nb = unit & 63;
        __syncthreads();
        { const int row = t >> 1, half = t & 1, pos = (nb - 1) * 128 + row;
          float kf[32], vf[32];
          if (pos >= 0) { const bf16* src = KVA + (size_t)(b * T + pos) * 256 + kvh * 64 + half * 32;
#pragma unroll
              for (int i = 0; i < 4; ++i) { unpack8(*(const v4u*)(src + 8 * i), kf + 8 * i); unpack8(*(const v4u*)(src + 128 + 8 * i), vf + 8 * i); } }
          else {
#pragma unroll
              for (int i = 0; i < 32; ++i) { kf[i] = 0.f; vf[i] = 0.f; } }
#pragma unroll
          for (int i = 0; i < 8; ++i) { *(LAS f32x4*)(KsL + row * 68 + half * 32 + 4 * i) = (f32x4){kf[4 * i], kf[4 * i + 1], kf[4 * i + 2], kf[4 * i + 3]};
                                        *(LAS f32x4*)(VsL + row * 68 + half * 32 + 4 * i) = (f32x4){vf[4 * i], vf[4 * i + 1], vf[4 * i + 2], vf[4 * i + 3]}; }
          const int g = t >> 7, dist = t & 127;
          BtL[t] = rel_bias[(int)T5_BUCKET[dist] * 8 + kvh * 4 + g] * LOG2E; }
        __syncthreads();
        const int g = t >> 7, i = t & 127, head = kvh * 4 + g; const size_t rowq = (size_t)b * T + nb * 128 + i;
        float q[64], o[64];
        { const bf16* qs = QA + rowq * 512 + head * 64;
#pragma unroll
          for (int k = 0; k < 8; ++k) unpack8(*(const v4u*)(qs + 8 * k), q + 8 * k); }
#pragma unroll
        for (int d = 0; d < 64; ++d) o[d] = 0.f;
        float mx = sinks[head] * LOG2E, l = 1.f;
        for (int dd = 0; dd < 128; ++dd) {
            const int j = i + 1 + dd;
            if (nb == 0 && j < 128) continue;
            float s = BtL[g * 128 + 127 - dd];
            const LAS float* kr = KsL + j * 68; const LAS float* vr = VsL + j * 68;
#pragma unroll
            for (int d = 0; d < 64; d += 4) { const f32x4 kv = *(const LAS f32x4*)(kr + d); s += q[d] * kv[0] + q[d + 1] * kv[1] + q[d + 2] * kv[2] + q[d + 3] * kv[3]; }
            const float mn = fmaxf(mx, s), cc = exp2f(mx - mn), p = exp2f(s - mn);
            l = l * cc + p; mx = mn;
#pragma unroll
            for (int d = 0; d < 64; d += 4) { const f32x4 vv = *(const LAS f32x4*)(vr + d); o[d] = o[d] * cc + p * vv[0]; o[d + 1] = o[d + 1] * cc + p * vv[1]; o[d + 2] = o[d + 2] * cc + p * vv[2]; o[d + 3] = o[d + 3] * cc + p * vv[3]; }
        }
        const float inv = 1.f / l;
        bf16* op = MIX + rowq * 1024 + head * 64;
#pragma unroll
        for (int k = 0; k < 8; ++k) { v4u w; w.x = pk2(o[8 * k] * inv, o[8 * k + 1] * inv); w.y = pk2(o[8 * k + 2] * inv, o[8 * k + 3] * inv); w.z = pk2(o[8 * k + 4] * inv, o[8 * k + 5] * inv); w.w = pk2(o[8 * k + 6] * inv, o[8 * k + 7] * inv);
            *(v4u*)(op + 8 * k) = w; }
    }
}

template <bool OUT> __device__ __forceinline__ void gla_naive_phase(const Ctx& C, const Params& P) {
    const int sub = C.tid >> 7, e = C.tid & 127;
    LAS float* R = (LAS float*)C.lds + sub * 7296;
    LAS float* Al = R, *Kl = R + 1024, *Ql = R + 2048, *Vl = R + 3072, *Ol = R + 5120, *Ll = R + 7168;
    const bf16* QG = (const bf16*)(P.ws + WS_QG); const bf16* KG = (const bf16*)(P.ws + WS_KG); const bf16* VG = (const bf16*)(P.ws + WS_VG); const bf16* GO = (const bf16*)(P.ws + WS_GO);
    const float* LA = (const float*)(P.ws + WS_LA); float* SLOC = (float*)(P.ws + WS_SLOC); float* ECUM = (float*)(P.ws + WS_ECUM); bf16* MIX = (bf16*)(P.ws + WS_MIX);
    const float* gng = P.in[7];
    for (int grp = blockIdx.x; grp < 128; grp += gridDim.x) {
        const int u = grp * 4 + sub, bh = u >> 4, j = u & 15, b = bh >> 2, h = bh & 3;
        const size_t tok0 = (size_t)b * T + j * 512;
        float S[64];
#pragma unroll
        for (int d = 0; d < 64; ++d) S[d] = 0.f;
        if (OUT) {
            for (int i = 0; i < j; ++i) { const int ui = bh * 16 + i;
#pragma unroll
                for (int d = 0; d < 64; ++d) S[d] = ECUM[ui * 64 + d] * S[d] + SLOC[((size_t)ui * 64 + d) * 128 + e]; }
        }
        float lsum = 0.f;
        for (int tb = 0; tb < 32; ++tb) {
            __syncthreads();
            { const int d = e & 63;
#pragma unroll
              for (int q = 0; q < 8; ++q) { const int r = (e >> 6) + 2 * q; const size_t tok = tok0 + tb * 16 + r;
                  const float la = LA[tok * 256 + h * 64 + d]; lsum += la; Al[r * 64 + d] = __expf(la);
                  Kl[r * 64 + d] = bf2f(KG[tok * 256 + h * 64 + d]);
                  if (OUT) Ql[r * 64 + d] = bf2f(QG[tok * 256 + h * 64 + d]); }
#pragma unroll
              for (int r = 0; r < 16; ++r) { const size_t tok = tok0 + tb * 16 + r; Vl[r * 128 + e] = bf2f(VG[tok * 512 + h * 128 + e]); } }
            __syncthreads();
            for (int r = 0; r < 16; ++r) {
                const float vt = Vl[r * 128 + e]; float o = 0.f;
#pragma unroll
                for (int d = 0; d < 64; d += 4) { const f32x4 a4 = *(const LAS f32x4*)(Al + r * 64 + d), k4 = *(const LAS f32x4*)(Kl + r * 64 + d);
                    S[d] = a4[0] * S[d] + k4[0] * vt; S[d + 1] = a4[1] * S[d + 1] + k4[1] * vt; S[d + 2] = a4[2] * S[d + 2] + k4[2] * vt; S[d + 3] = a4[3] * S[d + 3] + k4[3] * vt;
                    if (OUT) { const f32x4 q4 = *(const LAS f32x4*)(Ql + r * 64 + d); o += q4[0] * S[d] + q4[1] * S[d + 1] + q4[2] * S[d + 2] + q4[3] * S[d + 3]; } }
                if (OUT) Ol[r * 128 + e] = o;
            }
            if (OUT) {
                __syncthreads();
                const int ws2 = (C.tid >> 6) & 1, lane = C.lane;
                for (int rr = 0; rr < 8; ++rr) { const int r = ws2 * 8 + rr; const size_t tok = tok0 + tb * 16 + r;
                    const float x0 = Ol[r * 128 + lane], x1 = Ol[r * 128 + 64 + lane];
                    const float ss = wave_sum(x0 * x0 + x1 * x1); const float rn = 1.f / sqrtf(ss * (1.f / 128.f) + EPS);
                    const float g0 = bf2f(GO[tok * 512 + h * 128 + lane]), g1 = bf2f(GO[tok * 512 + h * 128 + 64 + lane]);
                    MIX[tok * 1024 + 512 + h * 128 + lane] = (bf16)f2bf(x0 * rn * gng[lane] * g0);
                    MIX[tok * 1024 + 512 + h * 128 + 64 + lane] = (bf16)f2bf(x1 * rn * gng[64 + lane] * g1); }
            }
        }
        if (!OUT) {
#pragma unroll
            for (int d = 0; d < 64; ++d) SLOC[((size_t)u * 64 + d) * 128 + e] = S[d];
            __syncthreads();
            Ll[e] = lsum;
            __syncthreads();
            if (e < 64) ECUM[u * 64 + e] = __expf(Ll[e] + Ll[e + 64]);
        }
    }
}


typedef float f32x16 __attribute__((ext_vector_type(16)));
typedef float f32x2_t __attribute__((ext_vector_type(2))); typedef __bf16 bf16x2_t __attribute__((ext_vector_type(2)));
typedef unsigned v2u __attribute__((ext_vector_type(2)));
__device__ __forceinline__ unsigned cvtpk(float lo, float hi) { f32x2_t v = {lo, hi}; bf16x2_t b = __builtin_convertvector(v, bf16x2_t); return __builtin_bit_cast(unsigned, b); }
constexpr int SWA_KL = 0, SWA_VT = 36864, SWA_BT = SWA_VT + 33280, SWA_LDS = SWA_BT + 3072;

__device__ __forceinline__ void swa_task(const Ctx& C, const bf16* QA, bf16* MIX, float sink2, int b, int kvh, int nb, int g, int qg) {
    const int lane = C.lane, c = lane & 31, h = lane >> 5, q0 = 32 * qg, head = kvh * 4 + g;
    const size_t rowq = (size_t)b * T + nb * 128 + q0 + c;
    const LAS unsigned char* L = C.lds;
    bf16x8 qf[4];
#pragma unroll
    for (int s = 0; s < 4; ++s) qf[s] = *(const bf16x8*)(QA + rowq * 512 + head * 64 + 16 * s + 8 * h);
    f32x16 S[5];
    const LAS float* bt = (const LAS float*)(L + SWA_BT) + g * 192 + 31 - c + 4 * h;
    float mloc = -INFINITY;
#pragma unroll
    for (int t = 0; t < 5; ++t) {
        const int j0 = q0 + 32 * t;
        if (nb == 0 && j0 < 128) {
#pragma unroll
            for (int r = 0; r < 16; ++r) S[t][r] = -INFINITY;
        } else {
            f32x16 acc;
#pragma unroll
            for (int r = 0; r < 16; ++r) acc[r] = bt[32 * t + (r & 3) + 8 * (r >> 2)];
            const LAS unsigned char* kp = L + SWA_KL + (j0 + c) * 144 + 16 * h;
#pragma unroll
            for (int s = 0; s < 4; ++s) { const bf16x8 kf = *(const LAS bf16x8*)(kp + 32 * s); acc = __builtin_amdgcn_mfma_f32_32x32x16_bf16(kf, qf[s], acc, 0, 0, 0); }
            S[t] = acc;
#pragma unroll
            for (int r = 0; r < 16; ++r) mloc = fmaxf(mloc, acc[r]);
        }
    }
    float m = fmaxf(mloc, __shfl_xor(mloc, 32)); m = fmaxf(m, sink2);
    float ls = 0.f;
    bf16x8 Pb[5][2];
#pragma unroll
    for (int t = 0; t < 5; ++t) {
#pragma unroll
        for (int r = 0; r < 16; ++r) { const float p = __builtin_amdgcn_exp2f(S[t][r] - m); S[t][r] = p; ls += p; }
#pragma unroll
        for (int s = 0; s < 2; ++s) { v4u w; w.x = cvtpk(S[t][8 * s], S[t][8 * s + 1]); w.y = cvtpk(S[t][8 * s + 2], S[t][8 * s + 3]); w.z = cvtpk(S[t][8 * s + 4], S[t][8 * s + 5]); w.w = cvtpk(S[t][8 * s + 6], S[t][8 * s + 7]);
            Pb[t][s] = __builtin_bit_cast(bf16x8, w); }
    }
    ls += __shfl_xor(ls, 32);
    const float inv = 1.f / (ls + __builtin_amdgcn_exp2f(sink2 - m));
    bf16* op = MIX + rowq * 1024 + head * 64 + 4 * h;
#pragma unroll
    for (int db = 0; db < 2; ++db) {
        f32x16 o;
#pragma unroll
        for (int r = 0; r < 16; ++r) o[r] = 0.f;
        const LAS unsigned char* vp = L + SWA_VT + (32 * db + c) * 520 + 2 * q0 + 8 * h;
#pragma unroll
        for (int t = 0; t < 5; ++t)
#pragma unroll
            for (int s = 0; s < 2; ++s) {
                const v2u lo = *(const LAS v2u*)(vp + 64 * t + 32 * s), hi = *(const LAS v2u*)(vp + 64 * t + 32 * s + 16);
                const v4u w = {lo.x, lo.y, hi.x, hi.y};
                o = __builtin_amdgcn_mfma_f32_32x32x16_bf16(__builtin_bit_cast(bf16x8, w), Pb[t][s], o, 0, 0, 0);
            }
#pragma unroll
        for (int rq = 0; rq < 4; ++rq) { v2u w; w.x = cvtpk(o[4 * rq] * inv, o[4 * rq + 1] * inv); w.y = cvtpk(o[4 * rq + 2] * inv, o[4 * rq + 3] * inv);
            *(v2u*)(op + 32 * db + 8 * rq) = w; }
    }
}

__device__ __forceinline__ void swa_mfma_phase(const Ctx& C, const Params& P) {
    const bf16* QA = (const bf16*)(P.ws + WS_QA); const bf16* KVA = (const bf16*)(P.ws + WS_KVA); bf16* MIX = (bf16*)(P.ws + WS_MIX);
    const float* sinks = P.in[8]; const float* rel_bias = P.in[9];
    const int t = C.tid;
    LAS unsigned char* L = C.lds;
    for (int unit = blockIdx.x; unit < 1024; unit += gridDim.x) {
        const int b = unit >> 7, kvh = (unit >> 6) & 1, nb = unit & 63;
        __syncthreads();
#pragma unroll
        for (int i = 0; i < 4; ++i) { const int ch = t + 512 * i, row = ch >> 3, seg = ch & 7, pos = (nb - 1) * 128 + row;
            v4u w = {0u, 0u, 0u, 0u};
            if (pos >= 0) w = *(const v4u*)(KVA + (size_t)(b * T + pos) * 256 + kvh * 64 + seg * 8);
            *(LAS v4u*)(L + SWA_KL + row * 144 + seg * 16) = w; }
#pragma unroll
        for (int i = 0; i < 2; ++i) { const int it = t + 512 * i, kp = it & 127, dg = it >> 7, pos = (nb - 1) * 128 + 2 * kp;
            v4u w0 = {0u, 0u, 0u, 0u}, w1 = {0u, 0u, 0u, 0u};
            if (pos >= 0) { const bf16* src = KVA + (size_t)(b * T + pos) * 256 + 128 + kvh * 64 + dg * 8; w0 = *(const v4u*)src; w1 = *(const v4u*)(src + 256); }
            LAS unsigned* vt = (LAS unsigned*)(L + SWA_VT + (dg * 8) * 520 + 4 * kp);
            vt[0 * 130] = (w0.x & 0xffffu) | (w1.x << 16); vt[1 * 130] = (w0.x >> 16) | (w1.x & 0xffff0000u);
            vt[2 * 130] = (w0.y & 0xffffu) | (w1.y << 16); vt[3 * 130] = (w0.y >> 16) | (w1.y & 0xffff0000u);
            vt[4 * 130] = (w0.z & 0xffffu) | (w1.z << 16); vt[5 * 130] = (w0.z >> 16) | (w1.z & 0xffff0000u);
            vt[6 * 130] = (w0.w & 0xffffu) | (w1.w << 16); vt[7 * 130] = (w0.w >> 16) | (w1.w & 0xffff0000u); }
        for (int x = t; x < 768; x += 512) { const int g = x / 192, xx = x % 192, dist = 159 - xx;
            float v = -INFINITY; if (dist >= 0 && dist < 128) v = rel_bias[(int)T5_BUCKET[dist] * 8 + kvh * 4 + g] * LOG2E;
            ((LAS float*)(L + SWA_BT))[x] = v; }
        __syncthreads();
        const int g = C.wave & 3, qg = C.wave >> 2;
        const float sink2 = sinks[kvh * 4 + g] * LOG2E;
        swa_task(C, QA, MIX, sink2, b, kvh, nb, g, qg);
        swa_task(C, QA, MIX, sink2, b, kvh, nb, g, qg + 2);
    }
}

typedef short bf16x4 __attribute__((ext_vector_type(4)));
constexpr int GL_QT = 0, GL_KT = 9216, GL_KTT = 18432, GL_VT = 27648, GL_EL = 46080, GL_TS = 46336, GL_OB = 48384, GL_LDS = GL_OB + 64 * 132 * 4;
template <bool OUT> __device__ __forceinline__ void gla_mfma_phase(const Ctx& C, const Params& P) {
    const bf16* QG = (const bf16*)(P.ws + WS_QG); const bf16* KG = (const bf16*)(P.ws + WS_KG); const bf16* VG = (const bf16*)(P.ws + WS_VG); const bf16* GO = (const bf16*)(P.ws + WS_GO);
    const float* LA = (const float*)(P.ws + WS_LA); float* SLOC = (float*)(P.ws + WS_SLOC); float* ECUM = (float*)(P.ws + WS_ECUM); bf16* MIX = (bf16*)(P.ws + WS_MIX);
    const float* gng = P.in[7];
    LAS unsigned char* L = C.lds;
    const int t = C.tid, lane = C.lane, w = C.wave, r16 = lane & 15, q = lane >> 4;
    const int ed = t & 63, erg = t >> 6;
    const int vv = t & 127, vjg = t >> 7;
    for (int u = blockIdx.x; u < 512; u += gridDim.x) {
        const int bh = u >> 4, j = u & 15, b = bh >> 2, h = bh & 3;
        const size_t tok0 = (size_t)b * T + j * 512;
        f32x4 S[4];
#pragma unroll
        for (int td = 0; td < 4; ++td) S[td] = (f32x4){0.f, 0.f, 0.f, 0.f};
        if (OUT) {
            for (int i = 0; i < j; ++i) { const int ui = bh * 16 + i;
#pragma unroll
                for (int td = 0; td < 4; ++td)
#pragma unroll
                    for (int rg = 0; rg < 4; ++rg) { const int d = 16 * td + 4 * q + rg; S[td][rg] = ECUM[ui * 64 + d] * S[td][rg] + SLOC[((size_t)ui * 64 + d) * 128 + 16 * w + r16]; } }
        }
        float logdec = 0.f;
        for (int ch = 0; ch < 8; ++ch) {
            const size_t tokc = tok0 + ch * 64;
            float pre[8];
            { const float* lap = LA + (tokc + 8 * erg) * 256 + h * 64 + ed; float a = 0.f;
#pragma unroll
              for (int i = 0; i < 8; ++i) { a += lap[i * 256]; pre[i] = a; } }
            float kraw[8], qraw[8];
            { const bf16* kp = KG + (tokc + 8 * erg) * 256 + h * 64 + ed; const bf16* qp = QG + (tokc + 8 * erg) * 256 + h * 64 + ed;
#pragma unroll
              for (int i = 0; i < 8; ++i) { kraw[i] = bf2f(kp[i * 256]); if (OUT) qraw[i] = bf2f(qp[i * 256]); } }
            unsigned short vraw[16];
            { const bf16* vp = VG + (tokc + 16 * vjg) * 512 + h * 128 + vv;
#pragma unroll
              for (int i = 0; i < 16; ++i) vraw[i] = vp[i * 512]; }
            ((LAS float*)(L + GL_TS))[erg * 64 + ed] = pre[7];
            __syncthreads();
            { float off = 0.f;
#pragma unroll
              for (int g = 0; g < 7; ++g) { const float tv = ((const LAS float*)(L + GL_TS))[g * 64 + ed]; off += (g < erg) ? tv : 0.f; }
              unsigned kt[8];
#pragma unroll
              for (int i = 0; i < 8; ++i) { const float bb = off + pre[i]; const float ep = __expf(bb), em = __expf(-bb);
                  kt[i] = f2bf(kraw[i] * em);
                  if (OUT) { *(LAS unsigned short*)(L + GL_QT + (8 * erg + i) * 144 + 2 * ed) = (unsigned short)f2bf(qraw[i] * ep);
                             *(LAS unsigned short*)(L + GL_KT + (8 * erg + i) * 144 + 2 * ed) = (unsigned short)kt[i]; }
                  if (i == 7 && erg == 7) { ((LAS float*)(L + GL_EL))[ed] = ep; logdec += bb; } }
              v4u kw = {kt[0] | (kt[1] << 16), kt[2] | (kt[3] << 16), kt[4] | (kt[5] << 16), kt[6] | (kt[7] << 16)};
              *(LAS v4u*)(L + GL_KTT + ed * 144 + erg * 16) = kw;
              v4u v0 = {(unsigned)vraw[0] | ((unsigned)vraw[1] << 16), (unsigned)vraw[2] | ((unsigned)vraw[3] << 16), (unsigned)vraw[4] | ((unsigned)vraw[5] << 16), (unsigned)vraw[6] | ((unsigned)vraw[7] << 16)};
              v4u v1 = {(unsigned)vraw[8] | ((unsigned)vraw[9] << 16), (unsigned)vraw[10] | ((unsigned)vraw[11] << 16), (unsigned)vraw[12] | ((unsigned)vraw[13] << 16), (unsigned)vraw[14] | ((unsigned)vraw[15] << 16)};
              *(LAS v4u*)(L + GL_VT + vv * 144 + vjg * 32) = v0; *(LAS v4u*)(L + GL_VT + vv * 144 + vjg * 32 + 16) = v1; }
            __syncthreads();
            if (OUT) {
                bf16x8 kA[4][2], qB[4][2];
#pragma unroll
                for (int x = 0; x < 4; ++x)
#pragma unroll
                    for (int s = 0; s < 2; ++s) { kA[x][s] = *(const LAS bf16x8*)(L + GL_KT + (16 * x + r16) * 144 + 64 * s + 16 * q); qB[x][s] = *(const LAS bf16x8*)(L + GL_QT + (16 * x + r16) * 144 + 64 * s + 16 * q); }
                v2u ATp[4][4];
#pragma unroll
                for (int ti = 0; ti < 4; ++ti)
#pragma unroll
                    for (int tj = 0; tj < 4; ++tj) {
                        if (tj > ti) { ATp[tj][ti] = (v2u){0u, 0u}; continue; }
                        f32x4 a = {0.f, 0.f, 0.f, 0.f};
                        a = __builtin_amdgcn_mfma_f32_16x16x32_bf16(kA[tj][0], qB[ti][0], a, 0, 0, 0);
                        a = __builtin_amdgcn_mfma_f32_16x16x32_bf16(kA[tj][1], qB[ti][1], a, 0, 0, 0);
                        if (tj == ti) {
#pragma unroll
                            for (int rg = 0; rg < 4; ++rg) a[rg] = (4 * q + rg <= r16) ? a[rg] : 0.f; }
                        ATp[tj][ti] = (v2u){cvtpk(a[0], a[1]), cvtpk(a[2], a[3])};
                    }
                const LAS unsigned char* vtp = L + GL_VT + (16 * w + r16) * 144 + 8 * q;
#pragma unroll
                for (int ti = 0; ti < 4; ++ti) {
                    f32x4 o = {0.f, 0.f, 0.f, 0.f};
#pragma unroll
                    for (int sp = 0; sp < 2; ++sp) {
                        if (2 * sp > ti) continue;
                        const v2u lo = *(const LAS v2u*)(vtp + 64 * sp), hi = *(const LAS v2u*)(vtp + 64 * sp + 32);
                        const v4u bw = {lo.x, lo.y, hi.x, hi.y};
                        const v4u aw = {ATp[2 * sp][ti].x, ATp[2 * sp][ti].y, ATp[2 * sp + 1][ti].x, ATp[2 * sp + 1][ti].y};
                        o = __builtin_amdgcn_mfma_f32_16x16x32_bf16(__builtin_bit_cast(bf16x8, aw), __builtin_bit_cast(bf16x8, bw), o, 0, 0, 0);
                    }
                    const LAS unsigned char* qtp = L + GL_QT + (16 * ti + r16) * 144 + 8 * q;
#pragma unroll
                    for (int s = 0; s < 2; ++s) {
                        const v2u lo = *(const LAS v2u*)(qtp + 64 * s), hi = *(const LAS v2u*)(qtp + 64 * s + 32);
                        const v4u aw = {lo.x, lo.y, hi.x, hi.y};
                        const v4u bw = {cvtpk(S[2 * s][0], S[2 * s][1]), cvtpk(S[2 * s][2], S[2 * s][3]), cvtpk(S[2 * s + 1][0], S[2 * s + 1][1]), cvtpk(S[2 * s + 1][2], S[2 * s + 1][3])};
                        o = __builtin_amdgcn_mfma_f32_16x16x32_bf16(__builtin_bit_cast(bf16x8, aw), __builtin_bit_cast(bf16x8, bw), o, 0, 0, 0);
                    }
                    LAS float* ob = (LAS float*)(L + GL_OB) + (16 * ti + 4 * q) * 132 + 16 * w + r16;
                    ob[0] = o[0]; ob[132] = o[1]; ob[264] = o[2]; ob[396] = o[3];
                }
            }
            {
                bf16x8 vB[2];
#pragma unroll
                for (int s = 0; s < 2; ++s) vB[s] = *(const LAS bf16x8*)(L + GL_VT + (16 * w + r16) * 144 + 64 * s + 16 * q);
#pragma unroll
                for (int td = 0; td < 4; ++td) {
#pragma unroll
                    for (int s = 0; s < 2; ++s) { const bf16x8 ka = *(const LAS bf16x8*)(L + GL_KTT + (16 * td + r16) * 144 + 64 * s + 16 * q); S[td] = __builtin_amdgcn_mfma_f32_16x16x32_bf16(ka, vB[s], S[td], 0, 0, 0); }
                    const f32x4 e4 = *(const LAS f32x4*)(L + GL_EL + (16 * td + 4 * q) * 4);
                    S[td] = S[td] * e4;
                }
            }
            if (OUT) {
                __syncthreads();
                const int row = t >> 3, seg = t & 7;
                const LAS float* ob = (const LAS float*)(L + GL_OB) + row * 132 + 16 * seg;
                f32x4 x[4]; float ss = 0.f;
#pragma unroll
                for (int i = 0; i < 4; ++i) { x[i] = *(const LAS f32x4*)(ob + 4 * i); ss += (x[i][0] * x[i][0] + x[i][1] * x[i][1]) + (x[i][2] * x[i][2] + x[i][3] * x[i][3]); }
                ss += __shfl_xor(ss, 1); ss += __shfl_xor(ss, 2); ss += __shfl_xor(ss, 4);
                const float rn = 1.f / sqrtf(ss * (1.f / 128.f) + EPS);
                const bf16* gop = GO + (tokc + row) * 512 + h * 128 + 16 * seg;
                float gf[16]; unpack8(*(const v4u*)gop, gf); unpack8(*(const v4u*)(gop + 8), gf + 8);
                const f32x4* gp = (const f32x4*)(gng + 16 * seg);
                unsigned ow[8];
#pragma unroll
                for (int i = 0; i < 4; ++i) { const f32x4 gg = gp[i]; const f32x4 y = x[i] * rn * gg;
                    ow[2 * i] = cvtpk(y[0] * gf[4 * i], y[1] * gf[4 * i + 1]); ow[2 * i + 1] = cvtpk(y[2] * gf[4 * i + 2], y[3] * gf[4 * i + 3]); }
                bf16* mp = MIX + (tokc + row) * 1024 + 512 + h * 128 + 16 * seg;
                *(v4u*)mp = (v4u){ow[0], ow[1], ow[2], ow[3]}; *(v4u*)(mp + 8) = (v4u){ow[4], ow[5], ow[6], ow[7]};
            }
        }
        if (!OUT) {
#pragma unroll
            for (int td = 0; td < 4; ++td)
#pragma unroll
                for (int rg = 0; rg < 4; ++rg) SLOC[((size_t)u * 64 + 16 * td + 4 * q + rg) * 128 + 16 * w + r16] = S[td][rg];
            if (erg == 7) ECUM[u * 64 + ed] = __expf(logdec);
        }
        __syncthreads();
    }
}
__global__ void __launch_bounds__(512, 2) fwd_kernel(Params P) {
    extern __shared__ __attribute__((aligned(16))) unsigned char lds[];
    Ctx C; C.lds = (LAS unsigned char*)lds; C.tid = threadIdx.x; C.lane = C.tid & 63; C.wave = __builtin_amdgcn_readfirstlane(C.tid >> 6);
    C.gw = blockIdx.x * 8 + C.wave; C.ngw = gridDim.x * 8;
    unsigned char* ws = P.ws;
    const float* ADA = (const float*)(ws + WS_ADA);
    bf16* XN = (bf16*)(ws + WS_XN);
    const int lo = P.ph_lo, hi = P.ph_hi;
    for (int u = C.tid; u < (LDS_BYTES - LDSCTL_OFF) / 4; u += 512) ((LAS unsigned*)(C.lds + LDSCTL_OFF))[u] = 0u;
    __syncthreads();
    XcdBarrier bar = xcd_barrier_post((unsigned*)(ws + WS_CTL) + CW_BAR, (volatile LAS unsigned*)(C.lds + MISC_OFF) + 8);
#define IN(k) (lo <= (k) && (k) < hi)
#define SEAM(k) do { if (IN(k) && IN((k) + 1)) xcd_barrier(bar); } while (0)

    if (IN(0)) p0_prologue(C, P);
    SEAM(0);
    if (IN(1)) xn_pass(C, P.in[0], ADA, 0, 1024, XN);
    SEAM(1);
    if (IN(2)) {
        pg8::Gemm g{XN, (const bf16*)(ws + WS_WIN), M, NPROJ, D}; pg8::StaticOrder S; S.init(M, NPROJ, gridDim.x, (int)blockIdx.x);
        pg8::EpiProj E{(bf16*)(ws + WS_QA), (bf16*)(ws + WS_KVA), (bf16*)(ws + WS_QG), (bf16*)(ws + WS_KG), (bf16*)(ws + WS_VG), (bf16*)(ws + WS_GO), (float*)(ws + WS_LA), P.in[6]};
        pg8::gemm_phase<pg8::EpiProj, pg8::StaticOrder, true, true>(C.lds, g, S, E);
    }
    SEAM(2);
    if (IN(3)) {
#if SWA_MFMA
        swa_mfma_phase(C, P);
#else
        swa_naive_phase(C, P);
#endif
        __syncthreads();
#if GLA_MFMA
        gla_mfma_phase<false>(C, P);
#else
        gla_naive_phase<false>(C, P);
#endif
    }
    SEAM(3);
    if (IN(4)) {
#if GLA_MFMA
        gla_mfma_phase<true>(C, P);
#else
        gla_naive_phase<true>(C, P);
#endif
    }
    SEAM(4);
    if (IN(5)) {
        pg8::Gemm g{(const bf16*)(ws + WS_MIX), (const bf16*)(ws + WS_WOUT), M, D, D}; pg8::StaticOrder S; S.init(M, D, gridDim.x, (int)blockIdx.x);
        pg8::EpiResid E{P.in[0], P.out, ADA + 2048};
        pg8::gemm_phase<pg8::EpiResid, pg8::StaticOrder, true, true>(C.lds, g, S, E);
    }
    SEAM(5);
    if (IN(6)) xn_pass(C, P.out, ADA, 3072, 4096, XN);
    SEAM(6);
    if (IN(7)) {
        pg8::Gemm g{XN, (const bf16*)(ws + WS_W1), M, FF, D}; pg8::StaticOrder S; S.init(M, FF, gridDim.x, (int)blockIdx.x);
        pg8::EpiRelu2 E{(bf16*)(ws + WS_H)};
        pg8::gemm_phase<pg8::EpiRelu2, pg8::StaticOrder, true, true>(C.lds, g, S, E);
    }
    SEAM(7);
    if (IN(8)) {
        pg8::Gemm g{(const bf16*)(ws + WS_H), (const bf16*)(ws + WS_W2), M, D, FF}; pg8::StaticOrder S; S.init(M, D, gridDim.x, (int)blockIdx.x);
        pg8::EpiResid E{P.out, P.out, ADA + 5120};
        pg8::gemm_phase<pg8::EpiResid, pg8::StaticOrder, true, true>(C.lds, g, S, E);
    }
    SEAM(8);
    if (IN(9)) final_norm_pass(C, P.out, P.in[13]);
#undef IN
#undef SEAM
}

extern "C" void kernel_launch(void* const* d_in, const int* in_sizes, int n_in, void* d_out, int out_size, void* d_ws, size_t ws_size, hipStream_t stream) {
    static int grid = 0;
    if (grid == 0) {
        if (n_in != 14 || in_sizes[0] != M * D || out_size != M * D || ws_size < WS_END) { fprintf(stderr, "kernel_launch: unexpected shapes: n_in %d in0 %d out %d ws %zu\n", n_in, n_in > 0 ? in_sizes[0] : -1, out_size, ws_size); grid = -1; return; }
        int dev = 0, cus = 0, per_cu = 0;
        if (hipGetDevice(&dev) != hipSuccess || hipDeviceGetAttribute(&cus, hipDeviceAttributeMultiprocessorCount, dev) != hipSuccess) { fprintf(stderr, "kernel_launch: device query failed\n"); grid = -1; return; }
        if (hipFuncSetAttribute((const void*)fwd_kernel, hipFuncAttributeMaxDynamicSharedMemorySize, LDS_BYTES) != hipSuccess) { fprintf(stderr, "kernel_launch: hipFuncSetAttribute failed\n"); grid = -1; return; }
        if (hipOccupancyMaxActiveBlocksPerMultiprocessor(&per_cu, (const void*)fwd_kernel, 512, LDS_BYTES) != hipSuccess || per_cu < 1) { fprintf(stderr, "kernel_launch: occupancy query says %d blocks per CU\n", per_cu); (void)hipGetLastError(); grid = -1; return; }
        grid = cus;
    }
    if (grid < 0) return;
    if (hipMemsetAsync((char*)d_ws + WS_CTL, 0, CTL_ZERO_BYTES, stream) != hipSuccess) { fprintf(stderr, "kernel_launch: memset failed\n"); return; }
    Params p{};
    for (int i = 0; i < 14; ++i) p.in[i] = (const float*)d_in[i];
    p.out = (float*)d_out; p.ws = (unsigned char*)d_ws;
    constexpr int NL = MK_N_LAUNCHES;
    for (int li = 0; li < NL; ++li) {
        if (NL == 1) { p.ph_lo = 0; p.ph_hi = NPHASE; } else { p.ph_lo = li; p.ph_hi = li + 1; }
        void* args[] = {&p};
        const hipError_t e = hipLaunchCooperativeKernel((const void*)fwd_kernel, dim3(grid), dim3(512), args, LDS_BYTES, stream);
        if (e != hipSuccess) { fprintf(stderr, "kernel_launch: cooperative launch %d failed: %s (grid %d)\n", li, hipGetErrorString(e), grid); break; }
    }
}
```
